# Optimizing an MI355X kernel written in HIP

```python
import jax, jax.numpy as jnp
from jax import lax
import numpy as np


D_MODEL = 1024
BATCH = 8
SEQ = 2048
DEPTH = 2
DEC_BATCH = 4
DEC_SEQ = 4096
PAST_LEN = 128

N_MIXERS = 2
N_ATTN_LAYERS = (DEPTH + 1) // 2
N_RET_LAYERS = DEPTH // 2
HEAD_DIM = 64
N_HEADS = D_MODEL // HEAD_DIM
N_KV_HEADS = 4
GROUP = N_HEADS // N_KV_HEADS
WINDOW = 128
BLOCK = 128
ROT_DIM = HEAD_DIM // 4
ROPE_THETA = 500000.0
Q_DIM = N_HEADS * HEAD_DIM
KV_DIM = N_KV_HEADS * HEAD_DIM
QKV_DIM = Q_DIM + 2 * KV_DIM
RET_HEADS = 4
RET_QK_DIM = D_MODEL // RET_HEADS
RET_V_TOTAL = 2 * D_MODEL
RET_V_DIM = RET_V_TOTAL // RET_HEADS
RET_IN_DIM = 2 * D_MODEL + 2 * RET_V_TOTAL
RET_THETA = 10000.0
CHUNK = 128
D_FF = 2816
FFN_RESIDUAL = 0.5
NORM_EPS = 1e-6

kernel_name = 'hybrid_bidir_swa_retention_macaron'


def rmsnorm(x, g):
    x32 = x.astype(jnp.float32)
    y = x32 * lax.rsqrt(jnp.mean(x32 * x32, axis=-1, keepdims=True) + NORM_EPS)
    return (y * g.astype(jnp.float32)).astype(x.dtype)


def rotary(x, n_rot, theta):
    L = x.shape[1]
    half = n_rot // 2
    inv_freq = theta ** (-jnp.arange(half, dtype=jnp.float32) / half)
    ang = jnp.arange(L, dtype=jnp.float32)[:, None] * inv_freq[None, :]
    cos = jnp.cos(ang)[None, :, None, :]
    sin = jnp.sin(ang)[None, :, None, :]
    xr = x[..., :n_rot].astype(jnp.float32)
    x1, x2 = xr[..., :half], xr[..., half:]
    rot = jnp.concatenate([x1 * cos - x2 * sin, x2 * cos + x1 * sin], axis=-1)
    return jnp.concatenate([rot.astype(x.dtype), x[..., n_rot:]], axis=-1)


def swiglu(h, w_in, w_out):
    gate, up = jnp.split(h @ w_in, 2, axis=-1)
    return (jax.nn.silu(gate) * up) @ w_out


def windowed_gqa(h, w_qkv, w_o, sink):
    B, L, _ = h.shape
    nb = L // BLOCK
    qkv = h @ w_qkv
    q = qkv[..., :Q_DIM].reshape(B, L, N_HEADS, HEAD_DIM)
    k = qkv[..., Q_DIM:Q_DIM + KV_DIM].reshape(B, L, N_KV_HEADS, HEAD_DIM)
    v = qkv[..., Q_DIM + KV_DIM:].reshape(B, L, N_KV_HEADS, HEAD_DIM)
    q = rotary(q, ROT_DIM, ROPE_THETA)
    k = rotary(k, ROT_DIM, ROPE_THETA)
    qb = q.reshape(B, nb, BLOCK, N_KV_HEADS, GROUP, HEAD_DIM)
    pad = ((0, 0), (BLOCK, BLOCK), (0, 0), (0, 0))
    kp = jnp.pad(k, pad).reshape(B, nb + 2, BLOCK, N_KV_HEADS, HEAD_DIM)
    vp = jnp.pad(v, pad).reshape(B, nb + 2, BLOCK, N_KV_HEADS, HEAD_DIM)
    kb = jnp.concatenate([kp[:, :-2], kp[:, 1:-1], kp[:, 2:]], axis=2)
    vb = jnp.concatenate([vp[:, :-2], vp[:, 1:-1], vp[:, 2:]], axis=2)
    s = jnp.einsum('bnqgrd,bnkgd->bngrqk', qb, kb).astype(jnp.float32) * (HEAD_DIM ** -0.5)
    qi = jnp.arange(BLOCK)
    kj = jnp.arange(3 * BLOCK)
    rel = kj[None, :] - BLOCK - qi[:, None]
    kpos = jnp.arange(nb)[:, None] * BLOCK + kj[None, :] - BLOCK
    valid = (jnp.abs(rel) <= WINDOW)[None] & ((kpos >= 0) & (kpos < L))[:, None, :]
    s = jnp.where(valid[None, :, None, None], s, -jnp.inf)
    sink_l = sink.astype(jnp.float32).reshape(N_KV_HEADS, GROUP)[None, None, :, :, None, None]
    m = jnp.maximum(jnp.max(s, axis=-1, keepdims=True), sink_l)
    p = jnp.exp(s - m)
    denom = jnp.sum(p, axis=-1, keepdims=True) + jnp.exp(sink_l - m)
    p = (p / denom).astype(vb.dtype)
    o = jnp.einsum('bngrqk,bnkgd->bnqgrd', p, vb).reshape(B, L, Q_DIM)
    return o @ w_o


def retention_direction(q, k, v, log_gamma, strict):
    B, L, H, dk = q.shape
    dv = v.shape[-1]
    nc = L // CHUNK
    i = jnp.arange(CHUNK, dtype=jnp.float32)
    diff = i[:, None] - i[None, :]
    mask = (diff > 0) if strict else (diff >= 0)
    decay = jnp.where(mask[None], jnp.exp(log_gamma[:, None, None] * jnp.maximum(diff, 0.0)[None]), 0.0)
    qc = q.reshape(B, nc, CHUNK, H, dk)
    kc = k.reshape(B, nc, CHUNK, H, dk)
    vc = v.reshape(B, nc, CHUNK, H, dv)
    s = jnp.einsum('bnihd,bnjhd->bnhij', qc, kc) * decay
    intra = jnp.einsum('bnhij,bnjhe->bnihe', s, vc)
    q_decay = jnp.exp(log_gamma[None, :] * (i[:, None] + 1.0))
    k_decay = jnp.exp(log_gamma[None, :] * (CHUNK - 1.0 - i)[:, None])
    chunk_decay = jnp.exp(log_gamma * CHUNK)

    def step(state, xs):
        qn, kn, vn = xs
        cross = jnp.einsum('bihd,bhde->bihe', qn, state) * q_decay[None, :, :, None]
        state = chunk_decay[None, :, None, None] * state + jnp.einsum(
            'bjhd,bjhe->bhde', kn * k_decay[None, :, :, None], vn)
        return state, cross

    state0 = jnp.zeros((B, H, dk, dv), jnp.float32)
    _, cross = lax.scan(step, state0, (jnp.moveaxis(qc, 1, 0), jnp.moveaxis(kc, 1, 0), jnp.moveaxis(vc, 1, 0)))
    out = intra + jnp.moveaxis(cross, 0, 1)
    return out.reshape(B, L, H, dv)


def retention(h, w_in, w_o, decay_fwd, decay_bwd):
    B, L, _ = h.shape
    proj = h @ w_in
    q = proj[..., :D_MODEL].reshape(B, L, RET_HEADS, RET_QK_DIM)
    k = proj[..., D_MODEL:2 * D_MODEL].reshape(B, L, RET_HEADS, RET_QK_DIM)
    v = proj[..., 2 * D_MODEL:2 * D_MODEL + RET_V_TOTAL].reshape(B, L, RET_HEADS, RET_V_DIM)
    g = proj[..., 2 * D_MODEL + RET_V_TOTAL:]
    q = rotary(q, RET_QK_DIM, RET_THETA).astype(jnp.float32)
    k = rotary(k, RET_QK_DIM, RET_THETA).astype(jnp.float32) * (RET_QK_DIM ** -0.5)
    v = v.astype(jnp.float32)
    lg_f = jax.nn.log_sigmoid(decay_fwd.astype(jnp.float32))
    lg_b = jax.nn.log_sigmoid(decay_bwd.astype(jnp.float32))
    y_f = retention_direction(q, k, v, lg_f, False)
    y_b = jnp.flip(retention_direction(jnp.flip(q, 1), jnp.flip(k, 1), jnp.flip(v, 1), lg_b, True), 1)
    y = y_f + y_b
    y = y * lax.rsqrt(jnp.mean(y * y, axis=-1, keepdims=True) + NORM_EPS)
    y = y.reshape(B, L, RET_V_TOTAL).astype(h.dtype)
    return (jax.nn.silu(g) * y) @ w_o


def trunk(x, norm_gains, ffn_w_in, ffn_w_out, attn_w_qkv, attn_w_o, attn_sink,
          ret_w_in, ret_w_o, ret_decay_fwd, ret_decay_bwd):
    for l in range(DEPTH):
        g = norm_gains[l]
        x = x + FFN_RESIDUAL * rmsnorm(swiglu(rmsnorm(x, g[0]), ffn_w_in[l, 0], ffn_w_out[l, 0]), g[1])
        h = rmsnorm(x, g[2])
        if l % N_MIXERS == 0:
            a = l // N_MIXERS
            mix = windowed_gqa(h, attn_w_qkv[a], attn_w_o[a], attn_sink[a])
        else:
            r = l // N_MIXERS
            mix = retention(h, ret_w_in[r], ret_w_o[r], ret_decay_fwd[r], ret_decay_bwd[r])
        x = x + rmsnorm(mix, g[3])
        x = x + FFN_RESIDUAL * rmsnorm(swiglu(rmsnorm(x, g[4]), ffn_w_in[l, 1], ffn_w_out[l, 1]), g[5])
    return x


def setup_inputs(seed: int = 0) -> dict:
    key = jax.random.key(seed)
    ks = jax.random.split(key, 14)
    f32 = jnp.float32
    base = 1.0 - 2.0 ** (-5.0 - np.arange(RET_HEADS))
    decay_logit = jnp.asarray(np.log(base / (1.0 - base)).astype(np.float32))[None, :]
    return {
        'x_prompt': jax.random.normal(ks[0], (BATCH, SEQ, D_MODEL), f32),
        'x_sample': jax.random.normal(ks[1], (DEC_BATCH, DEC_SEQ, D_MODEL), f32),
        'norm_gains': 1.0 + 0.05 * jax.random.normal(ks[2], (DEPTH, 6, D_MODEL), f32),
        'ffn_w_in': jax.random.normal(ks[3], (DEPTH, 2, D_MODEL, 2 * D_FF), f32) * D_MODEL ** -0.5,
        'ffn_w_out': jax.random.normal(ks[4], (DEPTH, 2, D_FF, D_MODEL), f32) * D_FF ** -0.5,
        'attn_w_qkv': jax.random.normal(ks[5], (N_ATTN_LAYERS, D_MODEL, QKV_DIM), f32) * D_MODEL ** -0.5,
        'attn_w_o': jax.random.normal(ks[6], (N_ATTN_LAYERS, Q_DIM, D_MODEL), f32) * Q_DIM ** -0.5,
        'attn_sink': 0.5 * jax.random.normal(ks[7], (N_ATTN_LAYERS, N_HEADS), f32),
        'ret_w_in': jax.random.normal(ks[8], (N_RET_LAYERS, D_MODEL, RET_IN_DIM), f32) * D_MODEL ** -0.5,
        'ret_w_o': jax.random.normal(ks[9], (N_RET_LAYERS, RET_V_TOTAL, D_MODEL), f32) * RET_V_TOTAL ** -0.5,
        'ret_decay_fwd': decay_logit + 0.01 * jax.random.normal(ks[10], (N_RET_LAYERS, RET_HEADS), f32),
        'ret_decay_bwd': decay_logit + 0.01 * jax.random.normal(ks[11], (N_RET_LAYERS, RET_HEADS), f32),
    }


def reference(x_prompt, x_sample, norm_gains, ffn_w_in, ffn_w_out, attn_w_qkv, attn_w_o, attn_sink,
              ret_w_in, ret_w_o, ret_decay_fwd, ret_decay_bwd):
    y_prompt = trunk(x_prompt, norm_gains, ffn_w_in, ffn_w_out, attn_w_qkv, attn_w_o, attn_sink,
                     ret_w_in, ret_w_o, ret_decay_fwd, ret_decay_bwd)
    y_sample = trunk(x_sample, norm_gains, ffn_w_in, ffn_w_out, attn_w_qkv, attn_w_o, attn_sink,
                     ret_w_in, ret_w_o, ret_decay_fwd, ret_decay_bwd)
    return (y_prompt, y_sample)
```

```cpp
#include <hip/hip_runtime.h>
#include <hip/hip_cooperative_groups.h>
#include <cstdio>
namespace cg = cooperative_groups;

#ifndef DUPMASK
#define DUPMASK 0
#endif
#ifndef PROBE_P
#define PROBE_P 23
#endif
#ifndef ONE_LAUNCH
#define ONE_LAUNCH 1
#endif

#define LAS __attribute__((address_space(3)))
#define DI __device__ __forceinline__
typedef unsigned short bf16_t;
typedef short bf16x8 __attribute__((ext_vector_type(8)));
typedef short s16x4 __attribute__((ext_vector_type(4)));
typedef float f32x4 __attribute__((ext_vector_type(4)));
typedef float f32x16 __attribute__((ext_vector_type(16)));
typedef unsigned u32x4 __attribute__((ext_vector_type(4)));
typedef unsigned u32x2 __attribute__((ext_vector_type(2)));

constexpr int T = 32768, TH = 16384, DM = 1024, DFF = 2816;
constexpr size_t MiB = 1048576;
constexpr size_t SZ_FFN_IN = 11 * MiB, OFF_FFN_OUT0 = 22 * MiB, SZ_FFN_OUT = 5767168, OFF_MIX_IN = 33 * MiB, OFF_MIX_OUT = 45 * MiB;
constexpr size_t OFF_COSA = 49 * MiB, OFF_SINA = OFF_COSA + 131072, OFF_COSR = OFF_SINA + 131072, OFF_SINR = OFF_COSR + 2 * MiB,
                 OFF_COSRT = OFF_SINR + 2 * MiB, OFF_SINRT = OFF_COSRT + 2 * MiB;
constexpr size_t OFF_SS = 58 * MiB, OFF_HF = 62 * MiB, OFF_BIG = 126 * MiB, WS_NEED = 350 * MiB;
constexpr int LDS_BYTES = 163840;
constexpr int NPHASE = 23;

struct Params {
  const float* xp; const float* xs; const float* gains; const float* ffn_in; const float* ffn_out; const float* wqkv; const float* wao;
  const float* sink; const float* wret_in; const float* wret_o; const float* dec_f; const float* dec_b;
  float* out; unsigned char* ws; int ph_lo, ph_hi; int wave_s; int pad_;
};

DI unsigned cvt_pk_bf16(float lo, float hi) { unsigned r; asm volatile("v_cvt_pk_bf16_f32 %0, %1, %2" : "=v"(r) : "v"(lo), "v"(hi)); return r; }
typedef __bf16 bf16v2_t __attribute__((ext_vector_type(2)));
typedef float f32v2_t __attribute__((ext_vector_type(2)));
DI unsigned rne_pk(float lo, float hi) {
  const f32v2_t v = {lo, hi};
  return __builtin_bit_cast(unsigned, __builtin_convertvector(v, bf16v2_t));
}
DI int tid_fresh(int wave_s) {
  int l; asm volatile("v_mbcnt_lo_u32_b32 %0, -1, 0\n\tv_mbcnt_hi_u32_b32 %0, -1, %0" : "=v"(l));
  return (wave_s << 6) | l; }
DI float bf_lo(unsigned w) { return __uint_as_float(w << 16); }
DI float bf_hi(unsigned w) { return __uint_as_float(w & 0xffff0000u); }
DI float silu_f(float x) { return x * __builtin_amdgcn_rcpf(1.0f + __expf(-x)); }
DI int tok_pos(int t) { return t < TH ? (t & 2047) : (t & 4095); }
DI float shx(float v, int lane, int mask) { return __int_as_float(__builtin_amdgcn_ds_bpermute((lane ^ mask) << 2, __float_as_int(v))); }
DI float wave_sum(float v, int lane) {
#pragma unroll
  for (int o = 32; o > 0; o >>= 1) v += shx(v, lane, o);
  return v;
}
DI bf16x8 ldg16(const void* base, unsigned boff) { return *(const bf16x8*)((const char*)base + boff); }
#define MFMA32(a, b, c) __builtin_amdgcn_mfma_f32_32x32x16_bf16((a), (b), (c), 0, 0, 0)
DI bf16x8 pack8(const f32x16& x, int s) {
  u32x4 p; p.x = rne_pk(x[8 * s], x[8 * s + 1]); p.y = rne_pk(x[8 * s + 2], x[8 * s + 3]); p.z = rne_pk(x[8 * s + 4], x[8 * s + 5]); p.w = rne_pk(x[8 * s + 6], x[8 * s + 7]);
  return __builtin_bit_cast(bf16x8, p);
}

constexpr int BM = 256, BK = 64, HALF = 128, HTB = HALF * BK * 2;
DI int lds_byte(int r, int c) { const int st = (r >> 4) * 2 + (c >> 5), rr = r & 15, cc = c & 31, ob = rr * 64 + cc * 2; return st * 1024 + (ob ^ (((ob >> 9) & 1) << 5)); }
DI void stage_rc(int b, int& R, int& C) { const int st = b / 1024, sb = b % 1024, swz = sb ^ (((sb >> 9) & 1) << 5); R = (st >> 1) * 16 + swz / 64; C = (st & 1) * 32 + (swz % 64) / 2; }
DI int perm32(int rho) { const int n = rho >> 4, i = rho & 15; return 8 * (i >> 2) + 4 * n + (i & 3); }
DI void tile_remap(int L, int nM, int nN, int& pm, int& pn) {
  const int nwg = nM * nN; int wgid = L;
  { const int q = nwg / 8, r = nwg % 8, xcd = wgid % 8, off = wgid / 8; wgid = (xcd < r ? xcd * (q + 1) : r * (q + 1) + (xcd - r) * q) + off; }
  const int nig = 8 * nN, gid = wgid / nig, fm = gid * 8, gsz = (nM - fm) < 8 ? (nM - fm) : 8;
  pm = fm + ((wgid % nig) % gsz); pn = (wgid % nig) / gsz;
}
struct Unit { const char* a; const char* b; int pm, pn, seg; };
typedef f32x4 Acc[2][2][4][2];

template <class PH>
DI void gemm_phase(LAS unsigned char* lds, const PH& ph, int wave_s) {
  const int tid = tid_fresh(wave_s), wid = __builtin_amdgcn_readfirstlane(tid >> 6), lane = tid & 63, wr = wid >> 2, wc = wid & 3, fr = lane & 15, fq = lane >> 4;
  const int K = ph.K, nt = K / BK;
  unsigned voffA[2], voffB[2];
#pragma unroll
  for (int i = 0; i < 2; ++i) { int R, C; stage_rc(tid * 16 + i * 8192, R, C); const int Rb = (R & ~31) + perm32(R & 31);
    voffA[i] = (unsigned)(R * K + C) * 2u; voffB[i] = (unsigned)(Rb * K + C) * 2u; }
  const size_t kstep = (size_t)(BK * 2);
  const size_t hstep = (size_t)HALF * K * 2;
  const unsigned ldsw = (unsigned)wid * 1024u;
  const int aoff = lds_byte(wr * 64 + fr, fq * 8), boff = lds_byte(wc * 32 + fr, fq * 8);
#define G_SA(b, h) (((b) * 2 + (h)) * HTB)
#define G_SB(b, h) ((4 + (b) * 2 + (h)) * HTB)
#define G_STAGE(bufoff, gbase, voff) do { _Pragma("unroll") for (int _i = 0; _i < 2; ++_i) \
    __builtin_amdgcn_global_load_lds((const unsigned*)((const char*)(gbase) + (voff)[_i]), (LAS unsigned*)(lds + (bufoff) + ldsw + _i * 8192), 16, 0, 0); } while (0)
#define G_LDA(dst, b, h) do { _Pragma("unroll") for (int m = 0; m < 4; ++m) _Pragma("unroll") for (int k = 0; k < 2; ++k) dst[m][k] = *(const LAS bf16x8*)(lds + G_SA(b, h) + aoff + m * 2048 + k * 1024); } while (0)
#define G_LDB(dst, b, h) do { _Pragma("unroll") for (int n = 0; n < 2; ++n) _Pragma("unroll") for (int k = 0; k < 2; ++k) dst[n][k] = *(const LAS bf16x8*)(lds + G_SB(b, h) + boff + n * 2048 + k * 1024); } while (0)
#define G_MMA(ai, bj, At, Bt) do { __builtin_amdgcn_s_setprio(1); _Pragma("unroll") for (int m = 0; m < 4; ++m) _Pragma("unroll") for (int n = 0; n < 2; ++n) _Pragma("unroll") for (int k = 0; k < 2; ++k) \
    acc[ai][bj][m][n] = __builtin_amdgcn_mfma_f32_16x16x32_bf16(Bt[n][k], At[m][k], acc[ai][bj][m][n], 0, 0, 0); __builtin_amdgcn_s_setprio(0); } while (0)
#define G_WAIT_V(n) asm volatile("s_waitcnt vmcnt(" #n ")" ::: "memory")
#define G_WAIT_L(n) asm volatile("s_waitcnt lgkmcnt(" #n ")" ::: "memory")
#define G_BAR __builtin_amdgcn_s_barrier()
#define G_SCHED __builtin_amdgcn_sched_barrier(0)
  Unit cur, nxt; int ui = 0;
  if (!ph.next(0, cur)) return;
  Acc acc;
#pragma unroll
  for (int a = 0; a < 2; ++a)
#pragma unroll
    for (int b = 0; b < 2; ++b)
#pragma unroll
      for (int m = 0; m < 4; ++m)
#pragma unroll
        for (int n = 0; n < 2; ++n) acc[a][b][m][n] = (f32x4){0.f, 0.f, 0.f, 0.f};
  bf16x8 At[4][2], B0[2][2], B1[2][2];
  const char* cA = cur.a; const char* cB = cur.b;
  G_STAGE(G_SB(0, 0), cB, voffB); G_STAGE(G_SB(0, 1), cB + hstep, voffB); G_STAGE(G_SA(0, 0), cA, voffA); G_STAGE(G_SA(0, 1), cA + hstep, voffA);
  if (wr == 1) G_BAR;
  G_WAIT_V(2); G_BAR;
  G_STAGE(G_SB(1, 0), cB + kstep, voffB); G_STAGE(G_SA(1, 0), cA + kstep, voffA); G_STAGE(G_SB(1, 1), cB + hstep + kstep, voffB);
  G_WAIT_V(6); G_BAR;
  for (;;) {
    const bool has_next = ph.next(ui + 1, nxt);
    const char* nA = has_next ? nxt.a : cA; const char* nB = has_next ? nxt.b : cB;
    for (int t = 0; t < nt; t += 2) {
      const bool last = (t == nt - 2);
      const char* a1 = cA + (size_t)(t + 1) * kstep;
      const char* a2 = last ? nA : cA + (size_t)(t + 2) * kstep; const char* b2 = last ? nB : cB + (size_t)(t + 2) * kstep;
      const char* a3 = a2 + kstep; const char* b3 = b2 + kstep;
      G_LDB(B0, 0, 0); G_LDB(B1, 0, 1); G_SCHED; G_LDA(At, 0, 0); G_STAGE(G_SA(1, 1), a1 + hstep, voffA);
      G_WAIT_V(8); G_WAIT_L(0); G_BAR; G_MMA(0, 0, At, B0); G_MMA(0, 1, At, B1); G_BAR; G_SCHED;
      G_LDA(At, 0, 1); G_STAGE(G_SB(0, 0), b2, voffB); G_STAGE(G_SB(0, 1), b2 + hstep, voffB); G_STAGE(G_SA(0, 0), a2, voffA);
      G_WAIT_V(8); G_WAIT_L(0); G_BAR; G_MMA(1, 0, At, B0); G_MMA(1, 1, At, B1); G_BAR; G_SCHED;
      G_LDB(B0, 1, 0); G_LDB(B1, 1, 1); G_SCHED; G_LDA(At, 1, 0); G_STAGE(G_SA(0, 1), a2 + hstep, voffA);
      G_WAIT_V(8); G_WAIT_L(0); G_BAR; G_MMA(0, 0, At, B0); G_MMA(0, 1, At, B1); G_BAR; G_SCHED;
      G_LDA(At, 1, 1); G_STAGE(G_SB(1, 0), b3, voffB); G_STAGE(G_SB(1, 1), b3 + hstep, voffB); G_STAGE(G_SA(1, 0), a3, voffA);
      G_WAIT_V(8); G_WAIT_L(0); G_BAR; G_MMA(1, 0, At, B0); G_MMA(1, 1, At, B1); G_BAR; G_SCHED;
    }
    if (wr == 0) G_BAR;
    ph.epi(acc, cur, wr, wc, fr, fq, lds);
    if (!has_next) break;
#pragma unroll
    for (int a = 0; a < 2; ++a)
#pragma unroll
      for (int b = 0; b < 2; ++b)
#pragma unroll
        for (int m = 0; m < 4; ++m)
#pragma unroll
          for (int n = 0; n < 2; ++n) acc[a][b][m][n] = (f32x4){0.f, 0.f, 0.f, 0.f};
    cur = nxt; cA = nA; cB = nB; ++ui;
    if (wr == 1) G_BAR;
  }
  G_WAIT_V(0);
  G_BAR;
#undef G_SA
#undef G_SB
#undef G_STAGE
#undef G_LDA
#undef G_LDB
#undef G_MMA
#undef G_WAIT_V
#undef G_WAIT_L
#undef G_BAR
#undef G_SCHED
}

DI void st16(void* base, unsigned boff, const u32x4& v) { *(u32x4*)((char*)base + boff) = v; }
DI f32x4 ldf4(const float* base, unsigned boff) { return *(const f32x4*)((const char*)base + boff); }
DI u32x4 pk8(const f32x4& v0, const f32x4& v1) { u32x4 w; w.x = cvt_pk_bf16(v0[0], v0[1]); w.y = cvt_pk_bf16(v0[2], v0[3]); w.z = cvt_pk_bf16(v1[0], v1[1]); w.w = cvt_pk_bf16(v1[2], v1[3]); return w; }

struct PhFfnIn {
  const char* A; const char* B; bf16_t* act; int K;
  DI bool next(int i, Unit& u) const { const int L = i * (int)gridDim.x + (int)blockIdx.x; if (L >= 128 * 22) return false; tile_remap(L, 128, 22, u.pm, u.pn); u.seg = 0;
    u.a = A + (size_t)u.pm * (256 * 1024 * 2); u.b = B + (size_t)u.pn * (256 * 1024 * 2); return true; }
  DI void epi(const Acc& acc, const Unit& u, int wr, int wc, int fr, int fq, LAS unsigned char* lds) const {
    const int row0 = u.pm * 256 + wr * 64 + fr, col0 = u.pn * 128 + wc * 32 + 8 * fq;
#pragma unroll
    for (int ai = 0; ai < 2; ++ai)
#pragma unroll
      for (int m = 0; m < 4; ++m) {
        f32x4 v0, v1;
#pragma unroll
        for (int j = 0; j < 4; ++j) { v0[j] = silu_f(acc[ai][0][m][0][j]) * acc[ai][1][m][0][j]; v1[j] = silu_f(acc[ai][0][m][1][j]) * acc[ai][1][m][1][j]; }
        st16(act, (unsigned)((row0 + ai * 128 + m * 16) * DFF + col0) * 2u, pk8(v0, v1));
      }
  }
};
struct PhOut {
  const char* A; const char* B; bf16_t* O; int K; int nM;
  DI bool next(int i, Unit& u) const { const int L = i * (int)gridDim.x + (int)blockIdx.x; if (L >= nM * 4) return false; tile_remap(L, nM, 4, u.pm, u.pn); u.seg = 0;
    u.a = A + (size_t)u.pm * 512 * K; u.b = B + (size_t)u.pn * 512 * K; return true; }
  DI void epi(const Acc& acc, const Unit& u, int wr, int wc, int fr, int fq, LAS unsigned char* lds) const {
    const int row0 = u.pm * 256 + wr * 64 + fr, col0 = u.pn * 256 + wc * 32 + 8 * fq;
#pragma unroll
    for (int ai = 0; ai < 2; ++ai)
#pragma unroll
      for (int m = 0; m < 4; ++m)
#pragma unroll
        for (int bj = 0; bj < 2; ++bj)
          st16(O, (unsigned)((row0 + ai * 128 + m * 16) * DM + col0 + bj * 128) * 2u, pk8(acc[ai][bj][m][0], acc[ai][bj][m][1]));
  }
};
constexpr size_t OFF_XCH = OFF_SS;
constexpr size_t OFF_CNT = 57 * MiB + 512 * 1024 + 256;
struct PhOutN {
  unsigned char* ws; const char* A; const char* B; int K, nM, rb, gi, ph, first, rep;
  DI bool next(int i, Unit& u) const { const int L = i * (int)gridDim.x + (int)blockIdx.x; if (L >= nM * 4) return false; tile_remap(L, nM, 4, u.pm, u.pn); u.seg = 0;
    u.a = A + (size_t)u.pm * 512 * K; u.b = B + (size_t)u.pn * 512 * K; return true; }
  DI void epi(const Acc& acc, const Unit& u, int wr, int wc, int fr_, int fq_, LAS unsigned char* lds) const {
    int fr = fr_, fq = fq_; asm volatile("" : "+v"(fr), "+v"(fq));
    typedef const __attribute__((address_space(4))) Params* KP;
    KP kp = (KP)__builtin_amdgcn_kernarg_segment_ptr();
    asm volatile("" : "+s"(kp));
    const float* gains = kp->gains; float* xout = kp->out; const float* xin_p = kp->xp; const float* xin_s = kp->xs;
    unsigned char* w2 = kp->ws;
    const float* gpost = gains + gi * DM; const float* gpre = gains + (gi + 1) * DM;
    const bool fin = gi == 11;
    const int lane = fq * 16 + fr, tid = (wr * 4 + wc) * 64 + lane;
    LAS float* part = (LAS float*)(lds + 131072);
    LAS float* stat = (LAS float*)(lds + 131072 + 16384);
    float* xch = (float*)(w2 + OFF_XCH); unsigned* cnt = (unsigned*)(w2 + OFF_CNT) + ph * 128 + u.pm;
    const int colw = u.pn * 256 + wc * 32 + 8 * fq;
    const int row0u = rb + u.pm * 256;
    const float* xsrc = row0u < TH ? xin_p : xin_s - (size_t)TH * DM;
    bf16_t* X = (bf16_t*)(w2 + OFF_HF);
    f32x4 gp[2][2];
#pragma unroll
    for (int bj = 0; bj < 2; ++bj) { gp[bj][0] = *(const f32x4*)(gpost + colw + bj * 128); gp[bj][1] = *(const f32x4*)(gpost + colw + bj * 128 + 4); }
#pragma unroll
    for (int ab = 0; ab < 4; ++ab) {
      const int ai = ab >> 1;
      f32x4 xb[4][4];
#pragma unroll
      for (int m = 2 * (ab & 1); m < 2 * (ab & 1) + 2; ++m) {
        const unsigned xo = (unsigned)((rb + u.pm * 256 + ai * 128 + wr * 64 + m * 16 + fr) * DM + colw) * 4u;
        if (first) {
#pragma unroll
          for (int q = 0; q < 4; ++q) xb[m][q] = ldf4(xsrc, xo + (unsigned)((q >> 1) * 512 + 16 * (q & 1)));
        } else {
#pragma unroll
          for (int bj = 0; bj < 2; ++bj) {
            const u32x4 wv = *(const u32x4*)((const char*)X + ((xo >> 1) + (unsigned)(bj * 256)));
            xb[m][bj * 2] = (f32x4){bf_lo(wv.x), bf_hi(wv.x), bf_lo(wv.y), bf_hi(wv.y)}; xb[m][bj * 2 + 1] = (f32x4){bf_lo(wv.z), bf_hi(wv.z), bf_lo(wv.w), bf_hi(wv.w)};
          }
        }
      }
#pragma unroll
      for (int m = 2 * (ab & 1); m < 2 * (ab & 1) + 2; ++m) {
        const int rl = ai * 128 + wr * 64 + m * 16 + fr;
        f32x4 sv = (f32x4){0.f, 0.f, 0.f, 0.f};
#pragma unroll
        for (int bj = 0; bj < 2; ++bj)
#pragma unroll
          for (int n = 0; n < 2; ++n) {
            const f32x4 x = xb[m][bj * 2 + n]; const f32x4 f = acc[ai][bj][m][n]; const f32x4 fp = f * gp[bj][n];
#pragma unroll
            for (int j = 0; j < 4; ++j) { sv[0] += f[j] * f[j]; sv[1] += x[j] * x[j]; sv[2] += x[j] * fp[j]; sv[3] += fp[j] * fp[j]; }
          }
#pragma unroll
        for (int e = 0; e < 4; ++e) { sv[e] += shx(sv[e], lane, 16); sv[e] += shx(sv[e], lane, 32); }
        if (fq == 0) *(LAS f32x4*)(part + (rl * 4 + wc) * 4) = sv;
      }
      __builtin_amdgcn_sched_barrier(0);
    }
    __syncthreads();
    if (tid < 256) {
      const f32x4 a = *(const LAS f32x4*)(part + (tid * 4 + 0) * 4), b = *(const LAS f32x4*)(part + (tid * 4 + 1) * 4), c = *(const LAS f32x4*)(part + (tid * 4 + 2) * 4), d = *(const LAS f32x4*)(part + (tid * 4 + 3) * 4);
      const f32x4 t = a + b + c + d;
      const unsigned so = (unsigned)((u.pm * 4 + u.pn) * 256 + tid) * 16u;
#pragma unroll
      for (int e = 0; e < 4; ++e) __hip_atomic_store((float*)((char*)xch + (so + 4u * e)), t[e], __ATOMIC_RELAXED, __HIP_MEMORY_SCOPE_AGENT);
    }
    asm volatile("s_waitcnt vmcnt(0)" ::: "memory");
    __syncthreads();
    if (tid == 0) {
      (void)__hip_atomic_fetch_add(cnt, 1u, __ATOMIC_RELAXED, __HIP_MEMORY_SCOPE_AGENT);
      unsigned spins = 0;
      while (__hip_atomic_load(cnt, __ATOMIC_RELAXED, __HIP_MEMORY_SCOPE_AGENT) < 4u * (unsigned)(1 + ((rep == 1 && ph < PROBE_P) ? 1 : 0))) { __builtin_amdgcn_s_sleep(1); if (++spins > (1u << 22)) break; }
    }
    __syncthreads();
    if (tid < 256) {
      f32x4 t = (f32x4){0.f, 0.f, 0.f, 0.f};
#pragma unroll
      for (int q = 0; q < 4; ++q) {
        const unsigned so = (unsigned)((u.pm * 4 + q) * 256 + tid) * 16u;
#pragma unroll
        for (int e = 0; e < 4; ++e) t[e] += __hip_atomic_load((const float*)((const char*)xch + (so + 4u * e)), __ATOMIC_RELAXED, __HIP_MEMORY_SCOPE_AGENT);
      }
      int gi2 = gi; asm volatile("" : "+s"(gi2));
      const float scale = (gi2 == 3 || gi2 == 9) ? 1.0f : 0.5f;
      const float al = scale * __builtin_amdgcn_rsqf(t[0] * (1.0f / 1024.0f) + 1e-6f);
      const float sx = t[1] + 2.0f * al * t[2] + al * al * t[3];
      stat[tid * 2] = al; stat[tid * 2 + 1] = __builtin_amdgcn_rsqf(fmaxf(sx, 0.f) * (1.0f / 1024.0f) + 1e-6f);
    }
    __syncthreads();
    bf16_t* hfp = (bf16_t*)xout;
#pragma unroll
    for (int ab = 0; ab < 4; ++ab) {
      const int ai = ab >> 1;
      f32x4 xb[4][4]; f32x4 gq[4];
#pragma unroll
      for (int m = 2 * (ab & 1); m < 2 * (ab & 1) + 2; ++m) {
        const unsigned xo = (unsigned)((rb + u.pm * 256 + ai * 128 + wr * 64 + m * 16 + fr) * DM + colw) * 4u;
        if (first) {
#pragma unroll
          for (int q = 0; q < 4; ++q) xb[m][q] = ldf4(xsrc, xo + (unsigned)((q >> 1) * 512 + 16 * (q & 1)));
        } else {
#pragma unroll
          for (int bj = 0; bj < 2; ++bj) {
            const u32x4 wv = *(const u32x4*)((const char*)X + ((xo >> 1) + (unsigned)(bj * 256)));
            xb[m][bj * 2] = (f32x4){bf_lo(wv.x), bf_hi(wv.x), bf_lo(wv.y), bf_hi(wv.y)}; xb[m][bj * 2 + 1] = (f32x4){bf_lo(wv.z), bf_hi(wv.z), bf_lo(wv.w), bf_hi(wv.w)};
          }
        }
      }
#pragma unroll
      for (int q = 0; q < 4; ++q) gq[q] = ldf4(gpre, (unsigned)(colw + (q >> 1) * 128 + 4 * (q & 1)) * 4u);
#pragma unroll
      for (int m = 2 * (ab & 1); m < 2 * (ab & 1) + 2; ++m) {
        const int rl = ai * 128 + wr * 64 + m * 16 + fr; const int row = rb + u.pm * 256 + rl;
        const unsigned xo = (unsigned)(row * DM + colw) * 4u;
        const float al = stat[rl * 2], rs2 = stat[rl * 2 + 1];
#pragma unroll
        for (int bj = 0; bj < 2; ++bj) {
          f32x4 xn[2];
#pragma unroll
          for (int n = 0; n < 2; ++n) xn[n] = xb[m][bj * 2 + n] + (acc[ai][bj][m][n] * gp[bj][n]) * al;
          if (fin) {
            *(f32x4*)((char*)xout + (xo + (unsigned)(bj * 512))) = xn[0]; *(f32x4*)((char*)xout + (xo + (unsigned)(bj * 512 + 16))) = xn[1];
          } else st16(X, (xo >> 1) + (unsigned)(bj * 256), pk8(xn[0], xn[1]));
          if (!fin) st16(hfp, (unsigned)(row * DM + colw + bj * 128) * 2u, pk8(xn[0] * gq[bj * 2] * rs2, xn[1] * gq[bj * 2 + 1] * rs2));
        }
      }
      __builtin_amdgcn_sched_barrier(0);
    }
  }
};
struct PhQkv {
  unsigned char* ws; const char* H; int K;
  DI bool next(int i, Unit& u) const { int L = i * (int)gridDim.x + (int)blockIdx.x; if (L >= 768) return false;
    const char* W = (const char*)(ws + OFF_MIX_IN);
    if (L < 640) { tile_remap(L, 128, 5, u.pm, u.pn); u.seg = 0; u.a = H + (size_t)u.pm * (512 * 1024); u.b = W + (size_t)u.pn * (512 * 1024); }
    else { L -= 640; u.pm = 0; u.pn = L; u.seg = 1; u.a = W + (size_t)1280 * 2048; u.b = H + (size_t)u.pn * (512 * 1024); }
    return true; }
  DI void epi(const Acc& acc, const Unit& u, int wr, int wc, int fr, int fq, LAS unsigned char* lds) const {
    unsigned char* w2 = ws; asm volatile("" : "+s"(w2));
    bf16_t* q = (bf16_t*)(w2 + OFF_BIG); bf16_t* k = (bf16_t*)(w2 + OFF_BIG + 64 * MiB); bf16_t* vT = (bf16_t*)(w2 + OFF_BIG + 80 * MiB);
    const float* cosA = (const float*)(w2 + OFF_COSA); const float* sinA = (const float*)(w2 + OFF_SINA);
    if (u.seg == 0) {
      const bool isq = u.pn < 4; const float sc = isq ? 0.125f : 1.0f;
      bf16_t* base = isq ? q + u.pn * 256 : k; const int ld = isq ? 1024 : 256;
      const bool rot = (wc & 1) == 0;
#pragma unroll
      for (int ai = 0; ai < 2; ++ai)
#pragma unroll
        for (int m = 0; m < 4; ++m) {
          const int row = u.pm * 256 + ai * 128 + wr * 64 + m * 16 + fr; const int pos = tok_pos(row);
#pragma unroll
          for (int bj = 0; bj < 2; ++bj) {
            f32x4 v0 = acc[ai][bj][m][0], v1 = acc[ai][bj][m][1];
            if (rot) {
              f32x4 o0, o1;
#pragma unroll
              for (int j = 0; j < 4; ++j) { o0[j] = shx(v0[j], fq * 16 + fr, 16); o1[j] = shx(v1[j], fq * 16 + fr, 16); }
              if (fq < 2) {
                const f32x4 c0 = ldf4(cosA, (unsigned)pos * 32u), c1 = ldf4(cosA, (unsigned)pos * 32u + 16u);
                f32x4 s0 = ldf4(sinA, (unsigned)pos * 32u), s1 = ldf4(sinA, (unsigned)pos * 32u + 16u);
                if (fq == 0) { s0 = -s0; s1 = -s1; }
                v0 = v0 * c0 + o0 * s0; v1 = v1 * c1 + o1 * s1;
              }
            }
            v0 *= sc; v1 *= sc;
            {
              const int hl = bj * 2 + (wc >> 1), head = isq ? u.pn * 4 + hl : hl, d0 = (wc & 1) * 32 + 8 * fq;
              st16(isq ? q : k, (unsigned)((((head * 1024 + (row >> 5)) * 4 + (d0 >> 4)) * 64 + ((d0 >> 3) & 1) * 32 + (row & 31)) * 16), pk8(v0, v1)); }
            __builtin_amdgcn_sched_barrier(0);
          }
        }
    } else {
#pragma unroll
      for (int ai = 0; ai < 2; ++ai)
#pragma unroll
        for (int m = 0; m < 4; ++m) {
          const int row = ai * 128 + wr * 64 + m * 16 + fr;
#pragma unroll
          for (int bj = 0; bj < 2; ++bj)
          {
            const int tl = u.pn * 256 + bj * 128 + wc * 32 + 8 * fq, ko = tl & 31;
            const unsigned bo = (unsigned)((((((row >> 6) * 1024 + (tl >> 5)) * 2 + ((row & 63) >> 5)) * 2 + (ko >> 4)) * 64 + (row & 31)) * 16 + ((ko >> 3) & 1) * 8);
            const u32x4 w = pk8(acc[ai][bj][m][0], acc[ai][bj][m][1]);
            *(u32x2*)((char*)vT + bo) = (u32x2){w.x, w.y};
            *(u32x2*)((char*)vT + bo + 512u) = (u32x2){w.z, w.w}; }
        }
    }
  }
};
template <int K> DI void tstage8(float (&v)[8], int lane) {
  const bool up = (lane & K) != 0;
#pragma unroll
  for (int j = 0; j < 8; ++j) {
    if ((j & K) == 0) {
      const float send = up ? v[j] : v[j | K];
      const float recv = shx(send, lane, K);
      if (up) v[j] = recv; else v[j | K] = recv;
    }
  }
}
DI void transpose8(float (&v)[8], int lane) { tstage8<4>(v, lane); tstage8<2>(v, lane); tstage8<1>(v, lane); }
struct PhRetIn {
  unsigned char* ws; const char* H; int rb; int K;
  DI bool next(int i, Unit& u) const { int L = i * (int)gridDim.x + (int)blockIdx.x; if (L >= 1024) return false;
    const char* W = (const char*)(ws + OFF_MIX_IN);
    if (L < 512) { tile_remap(L, 64, 8, u.pm, u.pn); u.seg = 0; u.a = H + (size_t)(rb + u.pm * 256) * 2048; u.b = W + (size_t)u.pn * (512 * 1024); }
    else { L -= 512; tile_remap(L, 8, 64, u.pm, u.pn); u.pm += 4; u.seg = 1; u.a = W + (size_t)(1024 + u.pm * 256) * 2048; u.b = H + (size_t)(rb + u.pn * 256) * 2048; }
    return true; }
  DI void epi(const Acc& acc, const Unit& u, int wr, int wc, int fr, int fq, LAS unsigned char* lds) const {
    unsigned char* w2 = ws; asm volatile("" : "+s"(w2));
    bf16_t* qr = (bf16_t*)(w2 + OFF_BIG); bf16_t* kr = (bf16_t*)(w2 + OFF_BIG + 32 * MiB); bf16_t* kT = (bf16_t*)(w2 + OFF_BIG + 64 * MiB); bf16_t* vT = (bf16_t*)(w2 + OFF_BIG + 96 * MiB);
    const float* cosR = (const float*)(w2 + OFF_COSR); const float* sinR = (const float*)(w2 + OFF_SINR); const float* cosRT = (const float*)(w2 + OFF_COSRT); const float* sinRT = (const float*)(w2 + OFF_SINRT);
    if (u.seg == 0) {
      const bool isq = u.pn < 4; const float sc = isq ? 1.0f : 0.0625f;
      bf16_t* base = isq ? qr : kr; const int hd = isq ? u.pn : u.pn - 4;
      const int d0 = wc * 32 + 8 * fq;
      const unsigned fo = (unsigned)hd * 65536u + (unsigned)(d0 >> 4) * 1024u + (unsigned)((d0 >> 3) & 1) * 512u;
#pragma unroll
      for (int ai = 0; ai < 2; ++ai)
#pragma unroll
        for (int m = 0; m < 4; ++m) {
          const int rl = u.pm * 256 + ai * 128 + wr * 64 + m * 16 + fr; const int pos = tok_pos(rb + rl);
          const unsigned to = (unsigned)(pos * 128 + d0) * 4u; const f32x4 c0 = ldf4(cosR, to), c1 = ldf4(cosR, to + 16u);
          const f32x4 s0 = ldf4(sinR, to), s1 = ldf4(sinR, to + 16u);
          const f32x4 a0 = acc[ai][0][m][0], a1 = acc[ai][0][m][1], b0 = acc[ai][1][m][0], b1 = acc[ai][1][m][1];
          const f32x4 x0 = (a0 * c0 - b0 * s0) * sc, x1 = (a1 * c1 - b1 * s1) * sc, y0 = (b0 * c0 + a0 * s0) * sc, y1 = (b1 * c1 + a1 * s1) * sc;
          const unsigned ro = fo + (unsigned)(rl >> 7) * 262144u + (unsigned)((rl >> 5) & 3) * 16384u + (unsigned)(rl & 31) * 16u;
          st16(base, ro, pk8(x0, x1));
          st16(base, ro + 8192u, pk8(y0, y1));
          if (!isq) {
            float vx[8] = {x0[0], x0[1], x0[2], x0[3], x1[0], x1[1], x1[2], x1[3]}, vy[8] = {y0[0], y0[1], y0[2], y0[3], y1[0], y1[1], y1[2], y1[3]};
            const int lane = fq * 16 + fr;
            transpose8(vx, lane); transpose8(vy, lane);
            const int tl = rl & ~7, dk = d0 + (fr & 7);
            const unsigned kro = (unsigned)((tl >> 7) * 4 + hd) * 65536u + (unsigned)(dk >> 5) * 8192u + (unsigned)((tl & 127) >> 4) * 1024u + (unsigned)((tl >> 3) & 1) * 512u + (unsigned)(dk & 31) * 16u;
            st16(kT, kro, pk8((f32x4){vx[0], vx[1], vx[2], vx[3]}, (f32x4){vx[4], vx[5], vx[6], vx[7]}));
            st16(kT, kro + 4u * 8192u, pk8((f32x4){vy[0], vy[1], vy[2], vy[3]}, (f32x4){vy[4], vy[5], vy[6], vy[7]}));
          }
          __builtin_amdgcn_sched_barrier(0);
        }
    } else if (u.pm < 4) {
      const int tl0 = u.pn * 256 + wc * 32 + 8 * fq;
#pragma unroll
      for (int m = 0; m < 4; ++m) {
        const int d = wr * 64 + m * 16 + fr;
#pragma unroll
        for (int bj = 0; bj < 2; ++bj) {
          const int tl = tl0 + bj * 128; const int pos = tok_pos(rb + tl);
          const unsigned to = (unsigned)(d * 4096 + pos) * 4u; const f32x4 c0 = ldf4(cosRT, to), c1 = ldf4(cosRT, to + 16u);
          const f32x4 s0 = ldf4(sinRT, to), s1 = ldf4(sinRT, to + 16u);
          const f32x4 a0 = acc[0][bj][m][0], a1 = acc[0][bj][m][1], b0 = acc[1][bj][m][0], b1 = acc[1][bj][m][1];
          const f32x4 x0 = (a0 * c0 - b0 * s0) * 0.0625f, x1 = (a1 * c1 - b1 * s1) * 0.0625f, y0 = (b0 * c0 + a0 * s0) * 0.0625f, y1 = (b1 * c1 + a1 * s1) * 0.0625f;
          const unsigned ro = (unsigned)((tl >> 7) * 4 + u.pm) * 65536u + (unsigned)(d >> 5) * 8192u + (unsigned)((tl & 127) >> 4) * 1024u + (unsigned)((tl >> 3) & 1) * 512u + (unsigned)(d & 31) * 16u;
          st16(kT, ro, pk8(x0, x1));
          st16(kT, ro + 4u * 8192u, pk8(y0, y1));
          __builtin_amdgcn_sched_barrier(0);
        }
      }
    } else {
#pragma unroll
      for (int ai = 0; ai < 2; ++ai)
#pragma unroll
        for (int m = 0; m < 4; ++m) {
          const int row = (u.pm - 4) * 256 + ai * 128 + wr * 64 + m * 16 + fr;
#pragma unroll
          for (int bj = 0; bj < 2; ++bj) {
            const int tl = u.pn * 256 + bj * 128 + wc * 32 + 8 * fq;
            const unsigned ro = (unsigned)((tl >> 7) * 4 + (row >> 9)) * 131072u + (unsigned)((row & 511) >> 5) * 8192u + (unsigned)((tl & 127) >> 4) * 1024u + (unsigned)((tl >> 3) & 1) * 512u + (unsigned)(row & 31) * 16u;
            st16(vT, ro, pk8(acc[ai][bj][m][0], acc[ai][bj][m][1]));
          }
        }
    }
  }
};
struct PhGate {
  const char* H; const char* W; bf16_t* y; const float* ss; int rb; int K;
  DI bool next(int i, Unit& u) const { const int L = i * (int)gridDim.x + (int)blockIdx.x; if (L >= 512) return false; tile_remap(L, 64, 8, u.pm, u.pn); u.seg = 0;
    u.a = H + (size_t)(rb + u.pm * 256) * 2048; u.b = W + (size_t)(4096 + u.pn * 256) * 2048; return true; }
  DI void epi(const Acc& acc, const Unit& u, int wr, int wc, int fr, int fq, LAS unsigned char* lds) const {
    const int hd = u.pn >> 1;
#pragma unroll
    for (int ai = 0; ai < 2; ++ai)
#pragma unroll
      for (int m = 0; m < 4; ++m) {
        const int rl = u.pm * 256 + ai * 128 + wr * 64 + m * 16 + fr;
        const unsigned so = (unsigned)(rl * 4 + hd) * 64u;
        const f32x4 p0 = ldf4(ss, so);
        const float rs = __builtin_amdgcn_rsqf((p0[0] + p0[1]) * (1.0f / 512.0f) + 1e-6f);
#pragma unroll
        for (int bj = 0; bj < 2; ++bj) {
          const unsigned yo = (unsigned)(rl * 2048 + u.pn * 256 + bj * 128 + wc * 32 + 8 * fq) * 2u;
          const u32x4 yv = *(const u32x4*)((const char*)y + yo);
          f32x4 v0, v1;
          v0[0] = silu_f(acc[ai][bj][m][0][0]) * bf_lo(yv.x) * rs; v0[1] = silu_f(acc[ai][bj][m][0][1]) * bf_hi(yv.x) * rs;
          v0[2] = silu_f(acc[ai][bj][m][0][2]) * bf_lo(yv.y) * rs; v0[3] = silu_f(acc[ai][bj][m][0][3]) * bf_hi(yv.y) * rs;
          v1[0] = silu_f(acc[ai][bj][m][1][0]) * bf_lo(yv.z) * rs; v1[1] = silu_f(acc[ai][bj][m][1][1]) * bf_hi(yv.z) * rs;
          v1[2] = silu_f(acc[ai][bj][m][1][2]) * bf_lo(yv.w) * rs; v1[3] = silu_f(acc[ai][bj][m][1][3]) * bf_hi(yv.w) * rs;
          st16(y, yo, pk8(v0, v1));
          __builtin_amdgcn_sched_barrier(0);
        }
      }
  }
};

DI void convert_mat(LAS float* tile, const float* src, int K, int N, bf16_t* dst, int ffn_in_mode, int wave_s) {
  const int tid = tid_fresh(wave_s), tk = K >> 6, tn = N >> 6;
  for (int t = blockIdx.x; t < tk * tn; t += gridDim.x) {
    const int kb = t % tk, nb = t / tk;
#pragma unroll
    for (int i = 0; i < 2; ++i) {
      const int r = (tid >> 4) + 32 * i, c = (tid & 15) * 4;
      const f32x4 v = *(const f32x4*)(src + (size_t)(kb * 64 + r) * N + nb * 64 + c);
      tile[r * 65 + c] = v[0]; tile[r * 65 + c + 1] = v[1]; tile[r * 65 + c + 2] = v[2]; tile[r * 65 + c + 3] = v[3];
    }
    __syncthreads();
    {
      const int n = tid >> 3, k0 = (tid & 7) * 8;
      float v[8];
#pragma unroll
      for (int j = 0; j < 8; ++j) v[j] = tile[(k0 + j) * 65 + n];
      int no = nb * 64 + n;
      if (ffn_in_mode) { const int half = no >= DFF ? 1 : 0; const int np = no - half * DFF; no = 256 * (np >> 7) + 128 * half + (np & 127); }
      u32x4 w; w.x = cvt_pk_bf16(v[0], v[1]); w.y = cvt_pk_bf16(v[2], v[3]); w.z = cvt_pk_bf16(v[4], v[5]); w.w = cvt_pk_bf16(v[6], v[7]);
      *(u32x4*)(dst + (size_t)no * K + kb * 64 + k0) = w;
    }
    __syncthreads();
  }
}
DI void convert_layer(LAS unsigned char* lds, const Params& p, int layer) {
  LAS float* tile = (LAS float*)lds;
  bf16_t* w = (bf16_t*)p.ws;
  for (int i = 0; i < 2; ++i) {
    convert_mat(tile, p.ffn_in + (size_t)(layer * 2 + i) * DM * 2 * DFF, DM, 2 * DFF, (bf16_t*)(p.ws + i * SZ_FFN_IN), 1, p.wave_s);
    convert_mat(tile, p.ffn_out + (size_t)(layer * 2 + i) * DFF * DM, DFF, DM, (bf16_t*)(p.ws + OFF_FFN_OUT0 + i * SZ_FFN_OUT), 0, p.wave_s);
  }
  if (layer == 0) {
    convert_mat(tile, p.wqkv, DM, 1536, (bf16_t*)(p.ws + OFF_MIX_IN), 0, p.wave_s);
    convert_mat(tile, p.wao, DM, DM, (bf16_t*)(p.ws + OFF_MIX_OUT), 0, p.wave_s);
  } else {
    convert_mat(tile, p.wret_in, DM, 6144, (bf16_t*)(p.ws + OFF_MIX_IN), 0, p.wave_s);
    convert_mat(tile, p.wret_o, 2048, DM, (bf16_t*)(p.ws + OFF_MIX_OUT), 0, p.wave_s);
  }
  (void)w;
}
DI void build_tables(const Params& p) {
  float* cosA = (float*)(p.ws + OFF_COSA); float* sinA = (float*)(p.ws + OFF_SINA);
  float* cosR = (float*)(p.ws + OFF_COSR); float* sinR = (float*)(p.ws + OFF_SINR);
  float* cosRT = (float*)(p.ws + OFF_COSRT); float* sinRT = (float*)(p.ws + OFF_SINRT);
  const int gt = blockIdx.x * 512 + tid_fresh(p.wave_s), gn = gridDim.x * 512;
  for (int e = gt; e < 4096 * 136; e += gn) {
    int pos, i; float invf;
    const bool isA = e < 4096 * 8;
    if (isA) { pos = e >> 3; i = e & 7; invf = exp2f(-(float)i * (18.931568569324174f / 8.0f)); }
    else { const int e2 = e - 4096 * 8; pos = e2 >> 7; i = e2 & 127; invf = exp2f(-(float)i * (13.287712379549449f / 128.0f)); }
    const double rev = (double)pos * (double)invf * 0.15915494309189535;
    const float fr = (float)(rev - rint(rev));
    const float c = __builtin_amdgcn_cosf(fr), s = __builtin_amdgcn_sinf(fr);
    if (isA) { cosA[e] = c; sinA[e] = s; }
    else { cosR[pos * 128 + i] = c; sinR[pos * 128 + i] = s; cosRT[i * 4096 + pos] = c; sinRT[i * 4096 + pos] = s; }
  }
}

DI void load_bf8(const bf16_t* p, float* v) { const u32x4 w = *(const u32x4*)p; v[0] = bf_lo(w.x); v[1] = bf_hi(w.x); v[2] = bf_lo(w.y); v[3] = bf_hi(w.y); v[4] = bf_lo(w.z); v[5] = bf_hi(w.z); v[6] = bf_lo(w.w); v[7] = bf_hi(w.w); }
DI void load_f8(const float* p, float* v) { const f32x4 a = *(const f32x4*)p, b = *(const f32x4*)(p + 4); v[0] = a[0]; v[1] = a[1]; v[2] = a[2]; v[3] = a[3]; v[4] = b[0]; v[5] = b[1]; v[6] = b[2]; v[7] = b[3]; }
DI void store_f8(float* p, const float* v) { *(f32x4*)p = (f32x4){v[0], v[1], v[2], v[3]}; *(f32x4*)(p + 4) = (f32x4){v[4], v[5], v[6], v[7]}; }
DI void store_bf8(bf16_t* p, const float* v) { u32x4 w; w.x = cvt_pk_bf16(v[0], v[1]); w.y = cvt_pk_bf16(v[2], v[3]); w.z = cvt_pk_bf16(v[4], v[5]); w.w = cvt_pk_bf16(v[6], v[7]); *(u32x4*)p = w; }

template <int MODE, bool FIRST, bool DRY = false>
DI void norm_phase(const Params& p, const float* gpost, float scale, const float* gpre) {
  bf16_t* hf = (bf16_t*)p.out;
  const int tidn = tid_fresh(p.wave_s); const int wid = tidn >> 6, lane = tidn & 63;
  for (int row = blockIdx.x * 8 + wid; row < T; row += gridDim.x * 8) {
    const float* xsrc = (MODE == 0 || FIRST) ? (row < TH ? p.xp + (size_t)row * DM : p.xs + (size_t)(row - TH) * DM) : p.out + (size_t)row * DM;
    float x[16];
    load_f8(xsrc + lane * 8, x); load_f8(xsrc + 512 + lane * 8, x + 8);
    if (MODE != 0) {
      float f[16], gp[16];
      load_bf8(hf + (size_t)row * DM + lane * 8, f); load_bf8(hf + (size_t)row * DM + 512 + lane * 8, f + 8);
      load_f8(gpost + lane * 8, gp); load_f8(gpost + 512 + lane * 8, gp + 8);
      float ss = 0.f;
#pragma unroll
      for (int j = 0; j < 16; ++j) ss += f[j] * f[j];
      ss = wave_sum(ss, lane);
      const float rs = __builtin_amdgcn_rsqf(ss * (1.0f / 1024.0f) + 1e-6f) * scale;
#pragma unroll
      for (int j = 0; j < 16; ++j) x[j] += f[j] * rs * gp[j];
      if (!DRY || rs == 12345.678f) { store_f8(p.out + (size_t)row * DM + lane * 8, x); store_f8(p.out + (size_t)row * DM + 512 + lane * 8, x + 8); }
    }
    if (MODE != 2) {
      float g[16];
      load_f8(gpre + lane * 8, g); load_f8(gpre + 512 + lane * 8, g + 8);
      float ss = 0.f;
#pragma unroll
      for (int j = 0; j < 16; ++j) ss += x[j] * x[j];
      ss = wave_sum(ss, lane);
      const float rs = __builtin_amdgcn_rsqf(ss * (1.0f / 1024.0f) + 1e-6f);
      float h[16];
#pragma unroll
      for (int j = 0; j < 16; ++j) h[j] = x[j] * rs * g[j];
      if (!DRY || rs == 12345.678f) { store_bf8(hf + (size_t)row * DM + lane * 8, h); store_bf8(hf + (size_t)row * DM + 512 + lane * 8, h + 8); }
    }
  }
}

DI void attn_phase(const Params& p) {
  const bf16_t* q = (const bf16_t*)(p.ws + OFF_BIG); const bf16_t* k = (const bf16_t*)(p.ws + OFF_BIG + 64 * MiB);
  const bf16_t* vT = (const bf16_t*)(p.ws + OFF_BIG + 80 * MiB); bf16_t* o = (bf16_t*)(p.ws + OFF_BIG + 96 * MiB);
  const int tida = tid_fresh(p.wave_s); const int w = tida >> 6, lane = tida & 63, r = lane & 31, h = lane >> 5;
  for (int item = blockIdx.x; item < 1024; item += gridDim.x) {
    const int g = item & 3, qb = item >> 2;
    const int t0 = qb * 128 + (w & 3) * 32, head0 = g * 4 + 2 * (w >> 2);
    const int s0 = t0 < TH ? (t0 & ~2047) : (t0 & ~4095), s1 = s0 + (t0 < TH ? 2048 : 4096);
    bf16x8 qf[2][4];
    float mrun[2], lrun[2];
    f32x16 o0[2], o1[2];
#pragma unroll
    for (int hh = 0; hh < 2; ++hh) {
#pragma unroll
      for (int s = 0; s < 4; ++s) qf[hh][s] = ldg16(q, (unsigned)((((head0 + hh) * 1024 + (t0 >> 5)) * 4 + s) * 64 + lane) * 16u);
      mrun[hh] = p.sink[head0 + hh]; lrun[hh] = 1.0f;
#pragma unroll
      for (int i = 0; i < 16; ++i) { o0[hh][i] = 0.f; o1[hh][i] = 0.f; }
    }
    const int ka_ = s0 - t0 + 128, kb_ = (s1 - t0 + 128) >> 5;
    const int kt_lo = ka_ > 0 ? (ka_ >> 5) : 0, kt_hi = kb_ < 9 ? kb_ : 9;
    bf16x8 kf[4], vf[4];
    {
      const int ks0 = t0 - 128 + 32 * kt_lo;
      const unsigned kofs0 = (unsigned)(((g * 1024 + (ks0 >> 5)) * 4) * 64 + lane) * 16u;
#pragma unroll
      for (int st = 0; st < 4; ++st) { kf[st] = ldg16(k, kofs0 + 1024u * st); vf[st] = ldg16(vT, kofs0 + 1024u * st); }
    }
    for (int kt = kt_lo; kt < kt_hi; ++kt) {
      const int ks = t0 - 128 + 32 * kt;
      const int ksn = kt + 1 < kt_hi ? ks + 32 : ks;
      const unsigned nofs = (unsigned)(((g * 1024 + (ksn >> 5)) * 4) * 64 + lane) * 16u;
      f32x16 s[2];
#pragma unroll
      for (int hh = 0; hh < 2; ++hh) {
#pragma unroll
        for (int i = 0; i < 16; ++i) s[hh][i] = 0.f;
#pragma unroll
        for (int st = 0; st < 4; ++st) s[hh] = MFMA32(kf[st], qf[hh][st], s[hh]);
      }
      asm volatile("" : "+v"(s[0]), "+v"(s[1]) :: "memory");
#pragma unroll
      for (int st = 0; st < 4; ++st) kf[st] = ldg16(k, nofs + 1024u * st);
      bf16x8 pb[2][2];
#pragma unroll
      for (int hh = 0; hh < 2; ++hh) {
        float mx = -INFINITY;
#pragma unroll
        for (int i = 0; i < 16; ++i) {
          const int d = (ks + (i & 3) + 8 * (i >> 2) + 4 * h) - (t0 + r);
          const bool valid = d >= -128 && d <= 128;
          s[hh][i] = valid ? s[hh][i] : -INFINITY; mx = fmaxf(mx, s[hh][i]);
        }
        mx = fmaxf(mx, shx(mx, lane, 32));
        const float mnew = fmaxf(mrun[hh], mx);
        const float alpha = __expf(mrun[hh] - mnew);
        float psum = 0.f;
#pragma unroll
        for (int i = 0; i < 16; ++i) { const float pe = __expf(s[hh][i] - mnew); s[hh][i] = pe; psum += pe; }
        psum += shx(psum, lane, 32);
        lrun[hh] = lrun[hh] * alpha + psum; mrun[hh] = mnew;
#pragma unroll
        for (int i = 0; i < 16; ++i) { o0[hh][i] *= alpha; o1[hh][i] *= alpha; }
        pb[hh][0] = pack8(s[hh], 0); pb[hh][1] = pack8(s[hh], 1);
      }
#pragma unroll
      for (int hh = 0; hh < 2; ++hh) {
        o0[hh] = MFMA32(vf[0], pb[hh][0], o0[hh]);
        o0[hh] = MFMA32(vf[1], pb[hh][1], o0[hh]);
        o1[hh] = MFMA32(vf[2], pb[hh][0], o1[hh]);
        o1[hh] = MFMA32(vf[3], pb[hh][1], o1[hh]);
      }
      asm volatile("" : "+v"(o0[0]), "+v"(o1[0]), "+v"(o0[1]), "+v"(o1[1]) :: "memory");
#pragma unroll
      for (int st = 0; st < 4; ++st) vf[st] = ldg16(vT, nofs + 1024u * st);
    }
#pragma unroll
    for (int hh = 0; hh < 2; ++hh) {
      const float inv = 1.0f / lrun[hh];
      bf16_t* op = o + (size_t)(t0 + r) * 1024 + (head0 + hh) * 64 + 4 * h;
#pragma unroll
      for (int gq = 0; gq < 4; ++gq) {
        u32x2 a, b;
        a.x = cvt_pk_bf16(o0[hh][4 * gq] * inv, o0[hh][4 * gq + 1] * inv); a.y = cvt_pk_bf16(o0[hh][4 * gq + 2] * inv, o0[hh][4 * gq + 3] * inv);
        b.x = cvt_pk_bf16(o1[hh][4 * gq] * inv, o1[hh][4 * gq + 1] * inv); b.y = cvt_pk_bf16(o1[hh][4 * gq + 2] * inv, o1[hh][4 * gq + 3] * inv);
        *(u32x2*)(op + 8 * gq) = a; *(u32x2*)(op + 32 + 8 * gq) = b;
      }
    }
  }
}

DI float log2_gamma(float x) { return -__builtin_amdgcn_logf(1.0f + __builtin_amdgcn_exp2f(-1.4426950408889634f * x)); }
#define EX2(x) __builtin_amdgcn_exp2f(x)
DI bf16x8 scale_frag(bf16x8 a, float a0, float a1, int jbase) {
  const u32x4 w = __builtin_bit_cast(u32x4, a); u32x4 o;
  const float b = a0 + a1 * (float)jbase;
  o.x = rne_pk(bf_lo(w.x) * EX2(b), bf_hi(w.x) * EX2(b + a1));
  o.y = rne_pk(bf_lo(w.y) * EX2(b + 2.f * a1), bf_hi(w.y) * EX2(b + 3.f * a1));
  o.z = rne_pk(bf_lo(w.z) * EX2(b + 4.f * a1), bf_hi(w.z) * EX2(b + 5.f * a1));
  o.w = rne_pk(bf_lo(w.w) * EX2(b + 6.f * a1), bf_hi(w.w) * EX2(b + 7.f * a1));
  return __builtin_bit_cast(bf16x8, o);
}
DI void lds_barrier() {
  asm volatile("s_waitcnt lgkmcnt(0)" ::: "memory"); __builtin_amdgcn_s_barrier(); asm volatile("" ::: "memory"); }
DI bf16x8 scale_tab(bf16x8 v, const LAS float* d) {
  const f32x4 d0 = *(const LAS f32x4*)d, d1 = *(const LAS f32x4*)(d + 4);
  const u32x4 wv = __builtin_bit_cast(u32x4, v); u32x4 o;
  o.x = cvt_pk_bf16(bf_lo(wv.x) * d0[0], bf_hi(wv.x) * d0[1]); o.y = cvt_pk_bf16(bf_lo(wv.y) * d0[2], bf_hi(wv.y) * d0[3]);
  o.z = cvt_pk_bf16(bf_lo(wv.z) * d1[0], bf_hi(wv.z) * d1[1]); o.w = cvt_pk_bf16(bf_lo(wv.w) * d1[2], bf_hi(wv.w) * d1[3]);
  return __builtin_bit_cast(bf16x8, o);
}
template <bool XW, int PASS, bool RMW>
DI void scan_pass(const bf16_t* qr, const bf16_t* kT, const bf16_t* vT, bf16_t* y, LAS bf16_t* Sb, LAS float* kdec, LAS unsigned char* vimg,
                  int tids, int lane, int r, int h, int w, int et, int dq, int icol, int nc,
                  unsigned qoff0, unsigned vaoff0, unsigned kboff0, unsigned yoff0, float lgf, float lgb) {
  constexpr int SBE = 64 * 264;
  constexpr int pass = PASS;
  {
    f32x16 st0, st1, st2, st3;
#pragma unroll
    for (int i = 0; i < 16; ++i) { st0[i] = 0.f; st1[i] = 0.f; st2[i] = 0.f; st3[i] = 0.f; }
    const float lg = pass == 0 ? lgf : lgb;
    const float cd = EX2(lg * 128.0f);
    const float qd = pass == 0 ? EX2(lgf * (float)(icol + 1)) : EX2(lgb * (float)(128 - icol));
    int pbuf = 0;
    if (tids < 128) kdec[tids] = EX2(lg * (float)(PASS == 0 ? 127 - tids : tids));
    __syncthreads();
    bf16x8 qf[16], vr[2], kb0[8], kb1[8];
    u32x2 ovn[8];
#pragma unroll
    for (int gq = 0; gq < 8; ++gq) { ovn[gq].x = 0u; ovn[gq].y = 0u; }
    {
      const int c0 = pass == 0 ? 0 : nc - 1, c1 = pass == 0 ? 1 : nc - 2;
      if constexpr (XW) {
#pragma unroll
        for (int s = 0; s < 16; ++s) qf[s] = ldg16(qr, qoff0 + (unsigned)c0 * 262144u + 1024u * s);
        if constexpr (PASS == 1 && RMW) {
#pragma unroll
          for (int gq = 0; gq < 8; ++gq) ovn[gq] = *(const u32x2*)((const char*)y + (yoff0 + (unsigned)c0 * 524288u + 64u * (gq >> 2) + 16u * (gq & 3)));
        }
      }
#pragma unroll
      for (int s = 0; s < 8; ++s) { if constexpr (!XW) { kb0[s] = ldg16(kT, kboff0 + (unsigned)c0 * 262144u + 1024u * s); kb1[s] = ldg16(kT, kboff0 + 8192u + (unsigned)c0 * 262144u + 1024u * s); } }
#pragma unroll
      for (int t = 0; t < 2; ++t) {
        const int sv = 2 * dq + t;
        const bf16x8 raw = ldg16(vT, vaoff0 + (unsigned)c0 * 524288u + 1024u * sv);
        *(LAS bf16x8*)(vimg + et * 8192 + sv * 1024 + lane * 16) = scale_tab(raw, kdec + 16 * sv + 8 * h);
        vr[t] = ldg16(vT, vaoff0 + (unsigned)c1 * 524288u + 1024u * sv);
      }
      lds_barrier();
    }
    for (int cc = 0; cc < nc; ++cc) {
      const int c = pass == 0 ? cc : nc - 1 - cc;
      const int k1 = cc + 1 < nc ? cc + 1 : nc - 1, k2 = cc + 2 < nc ? cc + 2 : nc - 1;
      const int cn = pass == 0 ? k1 : nc - 1 - k1, cnn = pass == 0 ? k2 : nc - 1 - k2;
      if constexpr (XW) {
        const unsigned yb = yoff0 + (unsigned)c * 524288u;
        f32x16 yc0, yc1;
#pragma unroll
        for (int i = 0; i < 16; ++i) { yc0[i] = 0.f; yc1[i] = 0.f; }
        const LAS bf16_t* sp = Sb + pbuf * SBE + r * 264 + 8 * h;
#pragma unroll
        for (int sb = 0; sb < 8; ++sb) {
          bf16x8 a0[2], a1[2];
#pragma unroll
          for (int k = 0; k < 2; ++k) { a0[k] = *(const LAS bf16x8*)(sp + 16 * (2 * sb + k)); a1[k] = *(const LAS bf16x8*)(sp + 32 * 264 + 16 * (2 * sb + k)); }
#pragma unroll
          for (int k = 0; k < 2; ++k) { yc0 = MFMA32(a0[k], qf[2 * sb + k], yc0); yc1 = MFMA32(a1[k], qf[2 * sb + k], yc1); }
        }
        asm volatile("" : "+v"(yc0), "+v"(yc1) :: "memory");
#pragma unroll
        for (int s = 0; s < 16; ++s) qf[s] = ldg16(qr, qoff0 + (unsigned)cn * 262144u + 1024u * s);
        const float qe = cc > 0 ? qd : 0.f;
#pragma unroll
        for (int gq = 0; gq < 4; ++gq) {
          u32x2 a; a.x = cvt_pk_bf16(bf_lo(ovn[gq].x) + qe * yc0[4 * gq], bf_hi(ovn[gq].x) + qe * yc0[4 * gq + 1]); a.y = cvt_pk_bf16(bf_lo(ovn[gq].y) + qe * yc0[4 * gq + 2], bf_hi(ovn[gq].y) + qe * yc0[4 * gq + 3]);
          *(u32x2*)((char*)y + (yb + 16u * gq)) = a;
          u32x2 c2; c2.x = cvt_pk_bf16(bf_lo(ovn[4 + gq].x) + qe * yc1[4 * gq], bf_hi(ovn[4 + gq].x) + qe * yc1[4 * gq + 1]); c2.y = cvt_pk_bf16(bf_lo(ovn[4 + gq].y) + qe * yc1[4 * gq + 2], bf_hi(ovn[4 + gq].y) + qe * yc1[4 * gq + 3]);
          *(u32x2*)((char*)y + (yb + 64u + 16u * gq)) = c2;
        }
        if constexpr (PASS == 1 && RMW) {
          const unsigned ybn = yoff0 + (unsigned)cn * 524288u;
#pragma unroll
          for (int gq = 0; gq < 8; ++gq) ovn[gq] = *(const u32x2*)((const char*)y + (ybn + 64u * (gq >> 2) + 16u * (gq & 3)));
        }
      }
      if constexpr (!XW) {
#pragma unroll
        for (int i = 0; i < 16; ++i) { st0[i] *= cd; st1[i] *= cd; st2[i] *= cd; st3[i] *= cd; }
#pragma unroll
        for (int sb = 0; sb < 2; ++sb) {
          bf16x8 a0[4], a1[4];
#pragma unroll
          for (int k = 0; k < 4; ++k) { a0[k] = *(const LAS bf16x8*)(vimg + (cc & 1) * 16384 + (4 * sb + k) * 1024 + lane * 16); a1[k] = *(const LAS bf16x8*)(vimg + (cc & 1) * 16384 + 8192 + (4 * sb + k) * 1024 + lane * 16); }
#pragma unroll
          for (int k = 0; k < 4; ++k) { st0 = MFMA32(a0[k], kb0[4 * sb + k], st0); st1 = MFMA32(a1[k], kb0[4 * sb + k], st1); st2 = MFMA32(a0[k], kb1[4 * sb + k], st2); st3 = MFMA32(a1[k], kb1[4 * sb + k], st3); }
          asm volatile("" : "+v"(st0), "+v"(st1), "+v"(st2), "+v"(st3) :: "memory");
#pragma unroll
          for (int k = 0; k < 4; ++k) { kb0[4 * sb + k] = ldg16(kT, kboff0 + (unsigned)cn * 262144u + 1024u * (4 * sb + k)); kb1[4 * sb + k] = ldg16(kT, kboff0 + 8192u + (unsigned)cn * 262144u + 1024u * (4 * sb + k)); }
        }
      }
#pragma unroll
      for (int t = 0; t < 2; ++t) {
        const int sv = 2 * dq + t;
        *(LAS bf16x8*)(vimg + ((cc + 1) & 1) * 16384 + et * 8192 + sv * 1024 + lane * 16) = scale_tab(vr[t], kdec + 16 * sv + 8 * h);
        vr[t] = ldg16(vT, vaoff0 + (unsigned)cnn * 524288u + 1024u * sv);
      }
      if constexpr (!XW) {
        LAS bf16_t* sw = Sb + (pbuf ^ 1) * SBE + (4 * h) * 264 + 64 * (w - 4) + r;
#pragma unroll
        for (int i = 0; i < 16; ++i) {
          const int eo = ((i & 3) + 8 * (i >> 2)) * 264;
          const unsigned pa = cvt_pk_bf16(st0[i], st1[i]), pb = cvt_pk_bf16(st2[i], st3[i]);
          sw[eo] = (bf16_t)(pa & 0xffffu); sw[eo + 32 * 264] = (bf16_t)(pa >> 16);
          sw[eo + 32] = (bf16_t)(pb & 0xffffu); sw[eo + 32 + 32 * 264] = (bf16_t)(pb >> 16);
        }
      }
      lds_barrier();
      pbuf ^= 1;
    }
  }
}
template <bool XW>
DI void scan_item(const bf16_t* qr, const bf16_t* kT, const bf16_t* vT, bf16_t* y, bf16_t* yb, int mode, LAS bf16_t* Sb, LAS float* kdec, LAS unsigned char* vimg,
                  int tids, int lane, int r, int h, int w, int et, int dq, int icol, int nc,
                  unsigned qoff0, unsigned vaoff0, unsigned kboff0, unsigned yoff0, float lgf, float lgb) {
  if (mode != 2) scan_pass<XW, 0, true>(qr, kT, vT, y, Sb, kdec, vimg, tids, lane, r, h, w, et, dq, icol, nc, qoff0, vaoff0, kboff0, yoff0, lgf, lgb);
  if (mode == 0) scan_pass<XW, 1, true>(qr, kT, vT, y, Sb, kdec, vimg, tids, lane, r, h, w, et, dq, icol, nc, qoff0, vaoff0, kboff0, yoff0, lgf, lgb);
  if (mode == 2) scan_pass<XW, 1, false>(qr, kT, vT, yb, Sb, kdec, vimg, tids, lane, r, h, w, et, dq, icol, nc, qoff0, vaoff0, kboff0, yoff0, lgf, lgb);
}
DI void scan_phase(LAS unsigned char* lds, const Params& p, int half) {
  const bf16_t* qr = (const bf16_t*)(p.ws + OFF_BIG);
  const bf16_t* kT = (const bf16_t*)(p.ws + OFF_BIG + 64 * MiB); const bf16_t* vT = (const bf16_t*)(p.ws + OFF_BIG + 96 * MiB);
  bf16_t* y = (bf16_t*)(p.ws + OFF_BIG + 160 * MiB);
  LAS bf16_t* Sb = (LAS bf16_t*)lds;
  LAS float* kdec = (LAS float*)(lds + 69632);
  LAS unsigned char* vimg = lds + 70656;
  const int L = half == 0 ? 2048 : 4096, nc = L / 128, npairs = half == 0 ? 32 : 16, per_xcd = npairs / 8;
  const int tids = tid_fresh(p.wave_s); const int w = p.wave_s, lane = tids & 63, r = lane & 31, h = lane >> 5, ib = w & 3, et = w >> 2, dq = w & 3;
  for (int i = tids; i < 2 * 64 * 264 / 2; i += 512) ((LAS unsigned*)lds)[i] = 0u;
  __syncthreads();
  bf16_t* yb = (bf16_t*)((char*)p.out + 64 * MiB);
  for (int bb = blockIdx.x; bb < 256; bb += gridDim.x) {
    const int jx = bb >> 3;
    int pair, sl, mode;
    if (half == 0) { pair = (bb & 7) * per_xcd + (jx >> 3); sl = jx & 7; mode = 0; }
    else { pair = (bb & 7) * per_xcd + (jx >> 4); sl = jx & 7; mode = 1 + ((jx >> 3) & 1); }
    const int hd = pair & 3, sq = pair >> 2;
    const float lgf = log2_gamma(p.dec_f[hd]), lgb = log2_gamma(p.dec_b[hd]);
    const int icol = 32 * ib + r;
    const int ch0 = sq * (L / 128);
    const unsigned qoff0 = (unsigned)(ch0 * 4 + hd) * 65536u + (unsigned)ib * 16384u + (unsigned)lane * 16u;
    const unsigned vaoff0 = (unsigned)(ch0 * 4 + hd) * 131072u + (unsigned)(2 * sl + et) * 8192u + (unsigned)lane * 16u;
    const unsigned kboff0 = (unsigned)(ch0 * 4 + hd) * 65536u + (unsigned)(w < 4 ? 0 : 2 * (w - 4)) * 8192u + (unsigned)lane * 16u;
    const unsigned yoff0 = (unsigned)((sq * L + icol) * 2048 + hd * 512 + 64 * sl + 4 * h) * 2u;
    if (w < 4) scan_item<true>(qr, kT, vT, y, yb, mode, Sb, kdec, vimg, tids, lane, r, h, w, et, dq, icol, nc, qoff0, vaoff0, kboff0, yoff0, lgf, lgb);
    else scan_item<false>(qr, kT, vT, y, yb, mode, Sb, kdec, vimg, tids, lane, r, h, w, et, dq, icol, nc, qoff0, vaoff0, kboff0, yoff0, lgf, lgb);
  }
}

template <bool DRY, bool H1>
DI void intra_phase(LAS unsigned char* lds, const Params& p) {
  const bf16_t* qr = (const bf16_t*)(p.ws + OFF_BIG); const bf16_t* kr = (const bf16_t*)(p.ws + OFF_BIG + 32 * MiB);
  const bf16_t* vT = (const bf16_t*)(p.ws + OFF_BIG + 96 * MiB);
  bf16_t* y = (bf16_t*)(p.ws + OFF_BIG + 160 * MiB); float* ss = (float*)(p.ws + OFF_SS);
  LAS unsigned char* Pimg = lds;
  const int tidi = tid_fresh(p.wave_s); const int w = tidi >> 6, lane = tidi & 63, r = lane & 31, h = lane >> 5, ib = w & 3, wh = w >> 2;
  const bf16_t* yb = (const bf16_t*)((const char*)p.out + 64 * MiB);
  for (int item = blockIdx.x; item < 512; item += gridDim.x) {
    const int hd = item & 3, tb = (item >> 2) * 128;
    const float lgf = log2_gamma(p.dec_f[hd]), lgb = log2_gamma(p.dec_b[hd]);
    const int icol = 32 * ib + r;
    {
      bf16x8 qf[16];
      const unsigned qo = (unsigned)(item) * 65536u + (unsigned)ib * 16384u + (unsigned)lane * 16u;
#pragma unroll
      for (int s = 0; s < 16; ++s) qf[s] = ldg16(qr, qo + 1024u * s);
#pragma unroll
      for (int jj = 0; jj < 2; ++jj) {
        const int jt = 2 * wh + jj;
        f32x16 pt;
#pragma unroll
        for (int i = 0; i < 16; ++i) pt[i] = 0.f;
        const unsigned ko = (unsigned)(item) * 65536u + (unsigned)jt * 16384u + (unsigned)lane * 16u;
#pragma unroll
        for (int s = 0; s < 16; ++s) pt = MFMA32(ldg16(kr, ko + 1024u * s), qf[s], pt);
#pragma unroll
        for (int gq = 0; gq < 4; ++gq) {
          float f[4];
#pragma unroll
          for (int e = 0; e < 4; ++e) {
            const int df = icol - (32 * jt + 8 * gq + 4 * h + e);
            f[e] = pt[4 * gq + e] * EX2(df >= 0 ? lgf * (float)df : lgb * (float)(-df));
          }
          u32x2 a; a.x = rne_pk(f[0], f[1]); a.y = rne_pk(f[2], f[3]);
          *(LAS u32x2*)(Pimg + icol * 272 + (32 * jt + 8 * gq + 4 * h) * 2) = a;
        }
      }
    }
    __syncthreads();
    {
      bf16x8 pf[8];
#pragma unroll
      for (int s = 0; s < 8; ++s) pf[s] = *(const LAS bf16x8*)(Pimg + icol * 272 + (16 * s + 8 * h) * 2);
      float sq2 = 0.f;
      const unsigned vo = (unsigned)(item) * 131072u + (unsigned)(8 * wh) * 8192u + (unsigned)lane * 16u;
      const unsigned yo = (unsigned)((tb + icol) * 2048 + hd * 512 + 256 * wh + 4 * h) * 2u;
      bf16x8 va[2][8]; u32x2 yold[2][4], yol2[2][4];
#pragma unroll
      for (int gq = 0; gq < 4; ++gq) { yol2[0][gq] = (u32x2){0u, 0u}; yol2[1][gq] = (u32x2){0u, 0u}; }
#pragma unroll
      for (int s = 0; s < 8; ++s) va[0][s] = ldg16(vT, vo + 1024u * s);
#pragma unroll
      for (int gq = 0; gq < 4; ++gq) { yold[0][gq] = *(const u32x2*)((const char*)y + (yo + 16u * gq)); if constexpr (H1) yol2[0][gq] = *(const u32x2*)((const char*)yb + (yo + 16u * gq)); }
#pragma unroll
      for (int t = 0; t < 8; ++t) {
        if (t < 7) {
#pragma unroll
          for (int s = 0; s < 8; ++s) va[(t + 1) & 1][s] = ldg16(vT, vo + (unsigned)(t + 1) * 8192u + 1024u * s);
#pragma unroll
          for (int gq = 0; gq < 4; ++gq) { yold[(t + 1) & 1][gq] = *(const u32x2*)((const char*)y + (yo + 64u * (t + 1) + 16u * gq)); if constexpr (H1) yol2[(t + 1) & 1][gq] = *(const u32x2*)((const char*)yb + (yo + 64u * (t + 1) + 16u * gq)); }
        }
        f32x16 yt;
#pragma unroll
        for (int i = 0; i < 16; ++i) yt[i] = 0.f;
#pragma unroll
        for (int s = 0; s < 8; ++s) yt = MFMA32(va[t & 1][s], pf[s], yt);
#pragma unroll
        for (int gq = 0; gq < 4; ++gq) {
          const u32x2 ov = yold[t & 1][gq], o2 = yol2[t & 1][gq];
          const float v0 = bf_lo(ov.x) + bf_lo(o2.x) + yt[4 * gq], v1 = bf_hi(ov.x) + bf_hi(o2.x) + yt[4 * gq + 1], v2 = bf_lo(ov.y) + bf_lo(o2.y) + yt[4 * gq + 2], v3 = bf_hi(ov.y) + bf_hi(o2.y) + yt[4 * gq + 3];
          sq2 += v0 * v0 + v1 * v1 + v2 * v2 + v3 * v3;
          u32x2 a; a.x = cvt_pk_bf16(v0, v1); a.y = cvt_pk_bf16(v2, v3); if (!DRY || v0 == 12345.678f) *(u32x2*)((char*)y + (yo + 64u * t + 16u * gq)) = a;
        }
        __builtin_amdgcn_sched_barrier(0);
      }
      sq2 += shx(sq2, lane, 32);
      if (h == 0 && (!DRY || sq2 == 12345.678f)) ss[((size_t)(tb + icol) * 4 + hd) * 16 + wh] = sq2;
    }
    __syncthreads();
  }
}

constexpr size_t OFF_BAR = 57 * MiB + 512 * 1024;
DI void grid_barrier(unsigned* bar, unsigned epoch) {
  asm volatile("s_waitcnt vmcnt(0)" ::: "memory");
  __syncthreads();
  if (threadIdx.x == 0) {
    __builtin_amdgcn_fence(__ATOMIC_RELEASE, "agent");
    asm volatile("s_waitcnt vmcnt(0)" ::: "memory");
    const unsigned G = gridDim.x, g = blockIdx.x & 7u, ngrp = (G + 7u - g) >> 3, ngroups = G < 8u ? G : 8u;
    unsigned* grp = bar + 3072 + 64 * g;
    const unsigned old = __hip_atomic_fetch_add(grp, 1u, __ATOMIC_RELAXED, __HIP_MEMORY_SCOPE_AGENT);
    if (old + 1u == ngrp * epoch) (void)__hip_atomic_fetch_add(bar, 1u, __ATOMIC_RELAXED, __HIP_MEMORY_SCOPE_AGENT);
    unsigned spins = 0;
    while (__hip_atomic_load(bar, __ATOMIC_RELAXED, __HIP_MEMORY_SCOPE_AGENT) < ngroups * epoch) { __builtin_amdgcn_s_sleep(1); if (++spins > (1u << 24)) break; }
    __builtin_amdgcn_fence(__ATOMIC_ACQUIRE, "agent");
    asm volatile("s_waitcnt vmcnt(0)" ::: "memory");
  }
  __syncthreads();
}

__global__ void __launch_bounds__(512, 2) fwd_megakernel(Params pin) {
  extern __shared__ __attribute__((aligned(16))) unsigned char shm[];
  LAS unsigned char* lds = (LAS unsigned char*)shm;
  const int wave_s = __builtin_amdgcn_readfirstlane((int)(threadIdx.x >> 6));
  const int ph_lo = pin.ph_lo, ph_hi = pin.ph_hi;
  unsigned nbar = 0;
#ifndef PROBE_P
#define PROBE_P 23
#endif
#if DUPMASK & 512
  for (int rep = 0; rep < 2; ++rep)
#else
  const int rep = 0;
#endif
  for (int ph = ph_lo; ph < ((DUPMASK & 512) && rep == 0 ? PROBE_P : ph_hi); ++ph) {
    typedef const __attribute__((address_space(4))) Params* KP;
    KP kp = (KP)__builtin_amdgcn_kernarg_segment_ptr();
    asm volatile("" : "+s"(kp));
    Params p;
    p.xp = kp->xp; p.xs = kp->xs; p.gains = kp->gains; p.ffn_in = kp->ffn_in; p.ffn_out = kp->ffn_out; p.wqkv = kp->wqkv; p.wao = kp->wao; p.sink = kp->sink;
    p.wret_in = kp->wret_in; p.wret_o = kp->wret_o; p.dec_f = kp->dec_f; p.dec_b = kp->dec_b; p.out = kp->out; p.ws = kp->ws; p.ph_lo = ph_lo; p.ph_hi = ph_hi; p.wave_s = wave_s; p.pad_ = 0;
    unsigned char* ws = p.ws;
    const char* hf = (const char*)p.out;
    const char* big = (const char*)(ws + OFF_BIG);
    const int layer = ph >= 9 ? 1 : 0;
    switch (ph) {
      case 0: case 8: convert_layer(lds, p, ph == 0 ? 0 : 1); if (ph == 0) { build_tables(p); norm_phase<0, true>(p, nullptr, 0.f, p.gains); } break;
      case 1: case 6: case 9: case 21: {
        const int i = (ph == 1 || ph == 9) ? 0 : 1;
        PhFfnIn g{hf, (const char*)(ws + i * SZ_FFN_IN), (bf16_t*)(ws + OFF_BIG), 1024};
#ifndef NO_FFNIN
        gemm_phase(lds, g, p.wave_s);
#endif
        } break;
      case 2: case 7: case 10: case 22: case 5: case 15: case 20: {
        PhOutN g;
        g.ws = ws; g.ph = ph; g.first = ph == 2 ? 1 : 0; g.rb = 0; g.nM = 128; g.rep = rep;
        if (ph == 5) { g.A = big + 96 * MiB; g.B = (const char*)(ws + OFF_MIX_OUT); g.K = 1024; g.gi = 3; }
        else if (ph == 15 || ph == 20) { g.A = big + 160 * MiB; g.B = (const char*)(ws + OFF_MIX_OUT); g.K = 2048; g.gi = 9; g.nM = 64; g.rb = ph == 15 ? 0 : TH; }
        else { const int i = (ph == 2 || ph == 10) ? 0 : 1; g.A = big; g.B = (const char*)(ws + OFF_FFN_OUT0 + i * SZ_FFN_OUT); g.K = DFF; g.gi = ph == 2 ? 1 : ph == 7 ? 5 : ph == 10 ? 7 : 11; }
#ifndef NO_OUT
        gemm_phase(lds, g, p.wave_s);
#endif
        } break;
      case 3: {
        PhQkv g{ws, hf, 1024};
#ifndef NO_QKV
        gemm_phase(lds, g, p.wave_s);
#endif
        } break;
#ifndef NO_ATTN
      case 4: attn_phase(p);
#if DUPMASK & 2
        attn_phase(p);
#endif
        break;
#endif
      case 11: case 16: {
        PhRetIn g{ws, hf, ph == 11 ? 0 : TH, 1024};
#ifndef NO_RETIN
        gemm_phase(lds, g, p.wave_s);
#endif
        } break;
#ifndef NO_SCAN
      case 12: case 17: scan_phase(lds, p, ph == 12 ? 0 : 1);
#if DUPMASK & 1
        scan_phase(lds, p, ph == 12 ? 0 : 1);
#endif
        break;
#endif
#ifndef NO_INTRA
      case 13: intra_phase<false, false>(lds, p); break;
      case 18: intra_phase<false, true>(lds, p); break;
#endif
      case 14: case 19: {
        PhGate g{hf, (const char*)(ws + OFF_MIX_IN), (bf16_t*)(ws + OFF_BIG + 160 * MiB), (const float*)(ws + OFF_SS), ph == 14 ? 0 : TH, 1024};
#ifndef NO_GATE
        gemm_phase(lds, g, p.wave_s);
#endif
        } break;
      default: break;
    }
    (void)layer;
#if ONE_LAUNCH
    if (ph + 1 < ph_hi || (DUPMASK & 512)) {
      if (ph_hi > NPHASE) cg::this_grid().sync();
      {
#if DUPMASK & 32
        if (ph == 1 && false) { for (int e = 0; e < 20; ++e) { nbar += 1; grid_barrier((unsigned*)(p.ws + OFF_BAR), nbar); } }
#endif
        if (ph != 15) { nbar += 1; grid_barrier((unsigned*)(p.ws + OFF_BAR), nbar); }
      }
    }
#endif
  }
}

extern "C" void kernel_launch(void* const* d_in, const int* in_sizes, int n_in, void* d_out, int out_size, void* d_ws, size_t ws_size, hipStream_t stream) {
  static int grid = 0;
  if (grid == 0) {
    if (ws_size < WS_NEED) { fprintf(stderr, "kernel_launch: workspace too small: %zu < %zu\n", ws_size, (size_t)WS_NEED); }
    int dev = 0, cus = 0, per_cu = 0;
    hipGetDevice(&dev);
    hipDeviceGetAttribute(&cus, hipDeviceAttributeMultiprocessorCount, dev);
    hipFuncSetAttribute((const void*)fwd_megakernel, hipFuncAttributeMaxDynamicSharedMemorySize, LDS_BYTES);
    hipOccupancyMaxActiveBlocksPerMultiprocessor(&per_cu, (const void*)fwd_megakernel, 512, LDS_BYTES);
    if (per_cu < 1) per_cu = 1;
    grid = cus * 1;
    (void)hipGetLastError();
  }
  Params p{};
  p.xp = (const float*)d_in[0]; p.xs = (const float*)d_in[1]; p.gains = (const float*)d_in[2]; p.ffn_in = (const float*)d_in[3]; p.ffn_out = (const float*)d_in[4];
  p.wqkv = (const float*)d_in[5]; p.wao = (const float*)d_in[6]; p.sink = (const float*)d_in[7]; p.wret_in = (const float*)d_in[8]; p.wret_o = (const float*)d_in[9];
  p.dec_f = (const float*)d_in[10]; p.dec_b = (const float*)d_in[11];
  p.out = (float*)d_out; p.ws = (unsigned char*)d_ws;
#if ONE_LAUNCH
  p.ph_lo = 0; p.ph_hi = NPHASE;
  (void)hipMemsetAsync((unsigned char*)d_ws + OFF_BAR, 0, 16384, stream);
  void* args[] = {&p};
  hipError_t e = hipLaunchCooperativeKernel((const void*)fwd_megakernel, dim3(grid), dim3(512), args, LDS_BYTES, stream);
  if (e != hipSuccess) fprintf(stderr, "cooperative launch failed: %s (grid %d)\n", hipGetErrorString(e), grid);
#else
  for (int ph = 0; ph < NPHASE; ++ph) {
    p.ph_lo = ph; p.ph_hi = ph + 1;
    hipLaunchKernelGGL(fwd_megakernel, dim3(grid), dim3(512), LDS_BYTES, stream, p);
  }
#endif
}
```

```cpp
#include <hip/hip_runtime.h>
#include <hip/hip_cooperative_groups.h>
#include <cstdio>
namespace cg = cooperative_groups;

#ifndef DUPMASK
#define DUPMASK 0
#endif
#ifndef PROBE_P
#define PROBE_P 23
#endif
#ifndef ONE_LAUNCH
#define ONE_LAUNCH 1
#endif

#define LAS __attribute__((address_space(3)))
#define DI __device__ __forceinline__
typedef unsigned short bf16_t;
typedef short bf16x8 __attribute__((ext_vector_type(8)));
typedef short s16x4 __attribute__((ext_vector_type(4)));
typedef float f32x4 __attribute__((ext_vector_type(4)));
typedef float f32x16 __attribute__((ext_vector_type(16)));
typedef unsigned u32x4 __attribute__((ext_vector_type(4)));
typedef unsigned u32x2 __attribute__((ext_vector_type(2)));

constexpr int T = 32768, TH = 16384, DM = 1024, DFF = 2816;
constexpr size_t MiB = 1048576;
constexpr size_t SZ_FFN_IN = 11 * MiB, OFF_FFN_OUT0 = 22 * MiB, SZ_FFN_OUT = 5767168, OFF_MIX_IN = 33 * MiB, OFF_MIX_OUT = 45 * MiB;
constexpr size_t OFF_COSA = 49 * MiB, OFF_SINA = OFF_COSA + 131072, OFF_COSR = OFF_SINA + 131072, OFF_SINR = OFF_COSR + 2 * MiB,
                 OFF_COSRT = OFF_SINR + 2 * MiB, OFF_SINRT = OFF_COSRT + 2 * MiB;
constexpr size_t OFF_SS = 58 * MiB, OFF_HF = 62 * MiB, OFF_BIG = 126 * MiB, WS_NEED = 350 * MiB;
constexpr int LDS_BYTES = 163840;
constexpr int NPHASE = 23;

struct Params {
  const float* xp; const float* xs; const float* gains; const float* ffn_in; const float* ffn_out; const float* wqkv; const float* wao;
  const float* sink; const float* wret_in; const float* wret_o; const float* dec_f; const float* dec_b;
  float* out; unsigned char* ws; int ph_lo, ph_hi; int wave_s; int pad_;
};

DI unsigned cvt_pk_bf16(float lo, float hi) { unsigned r; asm volatile("v_cvt_pk_bf16_f32 %0, %1, %2" : "=v"(r) : "v"(lo), "v"(hi)); return r; }
typedef __bf16 bf16v2_t __attribute__((ext_vector_type(2)));
typedef float f32v2_t __attribute__((ext_vector_type(2)));
DI unsigned rne_pk(float lo, float hi) {
  const f32v2_t v = {lo, hi};
  return __builtin_bit_cast(unsigned, __builtin_convertvector(v, bf16v2_t));
}
DI int tid_fresh(int wave_s) {
  int l; asm volatile("v_mbcnt_lo_u32_b32 %0, -1, 0\n\tv_mbcnt_hi_u32_b32 %0, -1, %0" : "=v"(l));
  return (wave_s << 6) | l; }
DI float bf_lo(unsigned w) { return __uint_as_float(w << 16); }
DI float bf_hi(unsigned w) { return __uint_as_float(w & 0xffff0000u); }
DI float silu_f(float x) { return x * __builtin_amdgcn_rcpf(1.0f + __expf(-x)); }
DI int tok_pos(int t) { return t < TH ? (t & 2047) : (t & 4095); }
DI float shx(float v, int lane, int mask) { return __int_as_float(__builtin_amdgcn_ds_bpermute((lane ^ mask) << 2, __float_as_int(v))); }
DI float wave_sum(float v, int lane) {
#pragma unroll
  for (int o = 32; o > 0; o >>= 1) v += shx(v, lane, o);
  return v;
}
DI bf16x8 ldg16(const void* base, unsigned boff) { return *(const bf16x8*)((const char*)base + boff); }
#define MFMA32(a, b, c) __builtin_amdgcn_mfma_f32_32x32x16_bf16((a), (b), (c), 0, 0, 0)
DI bf16x8 pack8(const f32x16& x, int s) {
  u32x4 p; p.x = rne_pk(x[8 * s], x[8 * s + 1]); p.y = rne_pk(x[8 * s + 2], x[8 * s + 3]); p.z = rne_pk(x[8 * s + 4], x[8 * s + 5]); p.w = rne_pk(x[8 * s + 6], x[8 * s + 7]);
  return __builtin_bit_cast(bf16x8, p);
}

constexpr int BM = 256, BK = 64, HALF = 128, HTB = HALF * BK * 2;
DI int lds_byte(int r, int c) { const int st = (r >> 4) * 2 + (c >> 5), rr = r & 15, cc = c & 31, ob = rr * 64 + cc * 2; return st * 1024 + (ob ^ (((ob >> 9) & 1) << 5)); }
DI void stage_rc(int b, int& R, int& C) { const int st = b / 1024, sb = b % 1024, swz = sb ^ (((sb >> 9) & 1) << 5); R = (st >> 1) * 16 + swz / 64; C = (st & 1) * 32 + (swz % 64) / 2; }
DI int perm32(int rho) { const int n = rho >> 4, i = rho & 15; return 8 * (i >> 2) + 4 * n + (i & 3); }
DI void tile_remap(int L, int nM, int nN, int& pm, int& pn) {
  const int nwg = nM * nN; int wgid = L;
  { const int q = nwg / 8, r = nwg % 8, xcd = wgid % 8, off = wgid / 8; wgid = (xcd < r ? xcd * (q + 1) : r * (q + 1) + (xcd - r) * q) + off; }
  const int nig = 8 * nN, gid = wgid / nig, fm = gid * 8, gsz = (nM - fm) < 8 ? (nM - fm) : 8;
  pm = fm + ((wgid % nig) % gsz); pn = (wgid % nig) / gsz;
}
struct Unit { const char* a; const char* b; int pm, pn, seg; };
typedef f32x4 Acc[2][2][4][2];

template <class PH>
DI void gemm_phase(LAS unsigned char* lds, const PH& ph, int wave_s) {
  const int tid = tid_fresh(wave_s), wid = __builtin_amdgcn_readfirstlane(tid >> 6), lane = tid & 63, wr = wid >> 2, wc = wid & 3, fr = lane & 15, fq = lane >> 4;
  const int K = ph.K, nt = K / BK;
  unsigned voffA[2], voffB[2];
#pragma unroll
  for (int i = 0; i < 2; ++i) { int R, C; stage_rc(tid * 16 + i * 8192, R, C); const int Rb = (R & ~31) + perm32(R & 31);
    voffA[i] = (unsigned)(R * K + C) * 2u; voffB[i] = (unsigned)(Rb * K + C) * 2u; }
  const size_t kstep = (size_t)(BK * 2);
  const size_t hstep = (size_t)HALF * K * 2;
  const unsigned ldsw = (unsigned)wid * 1024u;
  const int aoff = lds_byte(wr * 64 + fr, fq * 8), boff = lds_byte(wc * 32 + fr, fq * 8);
#define G_SA(b, h) (((b) * 2 + (h)) * HTB)
#define G_SB(b, h) ((4 + (b) * 2 + (h)) * HTB)
#define G_STAGE(bufoff, gbase, voff) do { _Pragma("unroll") for (int _i = 0; _i < 2; ++_i) \
    __builtin_amdgcn_global_load_lds((const unsigned*)((const char*)(gbase) + (voff)[_i]), (LAS unsigned*)(lds + (bufoff) + ldsw + _i * 8192), 16, 0, 0); } while (0)
#define G_LDA(dst, b, h) do { _Pragma("unroll") for (int m = 0; m < 4; ++m) _Pragma("unroll") for (int k = 0; k < 2; ++k) dst[m][k] = *(const LAS bf16x8*)(lds + G_SA(b, h) + aoff + m * 2048 + k * 1024); } while (0)
#define G_LDB(dst, b, h) do { _Pragma("unroll") for (int n = 0; n < 2; ++n) _Pragma("unroll") for (int k = 0; k < 2; ++k) dst[n][k] = *(const LAS bf16x8*)(lds + G_SB(b, h) + boff + n * 2048 + k * 1024); } while (0)
#define G_MMA(ai, bj, At, Bt) do { __builtin_amdgcn_s_setprio(1); _Pragma("unroll") for (int m = 0; m < 4; ++m) _Pragma("unroll") for (int n = 0; n < 2; ++n) _Pragma("unroll") for (int k = 0; k < 2; ++k) \
    acc[ai][bj][m][n] = __builtin_amdgcn_mfma_f32_16x16x32_bf16(Bt[n][k], At[m][k], acc[ai][bj][m][n], 0, 0, 0); __builtin_amdgcn_s_setprio(0); } while (0)
#define G_WAIT_V(n) asm volatile("s_waitcnt vmcnt(" #n ")" ::: "memory")
#define G_WAIT_L(n) asm volatile("s_waitcnt lgkmcnt(" #n ")" ::: "memory")
#define G_BAR __builtin_amdgcn_s_barrier()
#define G_SCHED __builtin_amdgcn_sched_barrier(0)
  Unit cur, nxt; int ui = 0;
  if (!ph.next(0, cur)) return;
  Acc acc;
#pragma unroll
  for (int a = 0; a < 2; ++a)
#pragma unroll
    for (int b = 0; b < 2; ++b)
#pragma unroll
      for (int m = 0; m < 4; ++m)
#pragma unroll
        for (int n = 0; n < 2; ++n) acc[a][b][m][n] = (f32x4){0.f, 0.f, 0.f, 0.f};
  bf16x8 At[4][2], B0[2][2], B1[2][2];
  const char* cA = cur.a; const char* cB = cur.b;
  G_STAGE(G_SB(0, 0), cB, voffB); G_STAGE(G_SB(0, 1), cB + hstep, voffB); G_STAGE(G_SA(0, 0), cA, voffA); G_STAGE(G_SA(0, 1), cA + hstep, voffA);
  if (wr == 1) G_BAR;
  G_WAIT_V(2); G_BAR;
  G_STAGE(G_SB(1, 0), cB + kstep, voffB); G_STAGE(G_SA(1, 0), cA + kstep, voffA); G_STAGE(G_SB(1, 1), cB + hstep + kstep, voffB);
  G_WAIT_V(6); G_BAR;
  for (;;) {
    const bool has_next = ph.next(ui + 1, nxt);
    const char* nA = has_next ? nxt.a : cA; const char* nB = has_next ? nxt.b : cB;
    for (int t = 0; t < nt; t += 2) {
      const bool last = (t == nt - 2);
      const char* a1 = cA + (size_t)(t + 1) * kstep;
      const char* a2 = last ? nA : cA + (size_t)(t + 2) * kstep; const char* b2 = last ? nB : cB + (size_t)(t + 2) * kstep;
      const char* a3 = a2 + kstep; const char* b3 = b2 + kstep;
      G_LDB(B0, 0, 0); G_LDB(B1, 0, 1); G_SCHED; G_LDA(At, 0, 0); G_STAGE(G_SA(1, 1), a1 + hstep, voffA);
      G_WAIT_V(8); G_WAIT_L(0); G_BAR; G_MMA(0, 0, At, B0); G_MMA(0, 1, At, B1); G_BAR; G_SCHED;
      G_LDA(At, 0, 1); G_STAGE(G_SB(0, 0), b2, voffB); G_STAGE(G_SB(0, 1), b2 + hstep, voffB); G_STAGE(G_SA(0, 0), a2, voffA);
      G_WAIT_V(8); G_WAIT_L(0); G_BAR; G_MMA(1, 0, At, B0); G_MMA(1, 1, At, B1); G_BAR; G_SCHED;
      G_LDB(B0, 1, 0); G_LDB(B1, 1, 1); G_SCHED; G_LDA(At, 1, 0); G_STAGE(G_SA(0, 1), a2 + hstep, voffA);
      G_WAIT_V(8); G_WAIT_L(0); G_BAR; G_MMA(0, 0, At, B0); G_MMA(0, 1, At, B1); G_BAR; G_SCHED;
      G_LDA(At, 1, 1); G_STAGE(G_SB(1, 0), b3, voffB); G_STAGE(G_SB(1, 1), b3 + hstep, voffB); G_STAGE(G_SA(1, 0), a3, voffA);
      G_WAIT_V(8); G_WAIT_L(0); G_BAR; G_MMA(1, 0, At, B0); G_MMA(1, 1, At, B1); G_BAR; G_SCHED;
    }
    if (wr == 0) G_BAR;
    ph.epi(acc, cur, wr, wc, fr, fq, lds);
    if (!has_next) break;
#pragma unroll
    for (int a = 0; a < 2; ++a)
#pragma unroll
      for (int b = 0; b < 2; ++b)
#pragma unroll
        for (int m = 0; m < 4; ++m)
#pragma unroll
          for (int n = 0; n < 2; ++n) acc[a][b][m][n] = (f32x4){0.f, 0.f, 0.f, 0.f};
    cur = nxt; cA = nA; cB = nB; ++ui;
    if (wr == 1) G_BAR;
  }
  G_WAIT_V(0);
  G_BAR;
#undef G_SA
#undef G_SB
#undef G_STAGE
#undef G_LDA
#undef G_LDB
#undef G_MMA
#undef G_WAIT_V
#undef G_WAIT_L
#undef G_BAR
#undef G_SCHED
}

DI void st16(void* base, unsigned boff, const u32x4& v) { *(u32x4*)((char*)base + boff) = v; }
DI f32x4 ldf4(const float* base, unsigned boff) { return *(const f32x4*)((const char*)base + boff); }
DI u32x4 pk8(const f32x4& v0, const f32x4& v1) { u32x4 w; w.x = cvt_pk_bf16(v0[0], v0[1]); w.y = cvt_pk_bf16(v0[2], v0[3]); w.z = cvt_pk_bf16(v1[0], v1[1]); w.w = cvt_pk_bf16(v1[2], v1[3]); return w; }

struct PhFfnIn {
  const char* A; const char* B; bf16_t* act; int K;
  DI bool next(int i, Unit& u) const { const int L = i * (int)gridDim.x + (int)blockIdx.x; if (L >= 128 * 22) return false; tile_remap(L, 128, 22, u.pm, u.pn); u.seg = 0;
    u.a = A + (size_t)u.pm * (256 * 1024 * 2); u.b = B + (size_t)u.pn * (256 * 1024 * 2); return true; }
  DI void epi(const Acc& acc, const Unit& u, int wr, int wc, int fr, int fq, LAS unsigned char* lds) const {
    const int row0 = u.pm * 256 + wr * 64 + fr, col0 = u.pn * 128 + wc * 32 + 8 * fq;
#pragma unroll
    for (int ai = 0; ai < 2; ++ai)
#pragma unroll
      for (int m = 0; m < 4; ++m) {
        f32x4 v0, v1;
#pragma unroll
        for (int j = 0; j < 4; ++j) { v0[j] = silu_f(acc[ai][0][m][0][j]) * acc[ai][1][m][0][j]; v1[j] = silu_f(acc[ai][0][m][1][j]) * acc[ai][1][m][1][j]; }
        st16(act, (unsigned)((row0 + ai * 128 + m * 16) * DFF + col0) * 2u, pk8(v0, v1));
      }
  }
};
struct PhOut {
  const char* A; const char* B; bf16_t* O; int K; int nM;
  DI bool next(int i, Unit& u) const { const int L = i * (int)gridDim.x + (int)blockIdx.x; if (L >= nM * 4) return false; tile_remap(L, nM, 4, u.pm, u.pn); u.seg = 0;
    u.a = A + (size_t)u.pm * 512 * K; u.b = B + (size_t)u.pn * 512 * K; return true; }
  DI void epi(const Acc& acc, const Unit& u, int wr, int wc, int fr, int fq, LAS unsigned char* lds) const {
    const int row0 = u.pm * 256 + wr * 64 + fr, col0 = u.pn * 256 + wc * 32 + 8 * fq;
#pragma unroll
    for (int ai = 0; ai < 2; ++ai)
#pragma unroll
      for (int m = 0; m < 4; ++m)
#pragma unroll
        for (int bj = 0; bj < 2; ++bj)
          st16(O, (unsigned)((row0 + ai * 128 + m * 16) * DM + col0 + bj * 128) * 2u, pk8(acc[ai][bj][m][0], acc[ai][bj][m][1]));
  }
};
constexpr size_t OFF_XCH = OFF_SS;
constexpr size_t OFF_CNT = 57 * MiB + 512 * 1024 + 256;
struct PhOutN {
  unsigned char* ws; const char* A; const char* B; int K, nM, rb, gi, ph, first, rep;
  DI bool next(int i, Unit& u) const { const int L = i * (int)gridDim.x + (int)blockIdx.x; if (L >= nM * 4) return false; tile_remap(L, nM, 4, u.pm, u.pn); u.seg = 0;
    u.a = A + (size_t)u.pm * 512 * K; u.b = B + (size_t)u.pn * 512 * K; return true; }
  DI void epi(const Acc& acc, const Unit& u, int wr, int wc, int fr_, int fq_, LAS unsigned char* lds) const {
    int fr = fr_, fq = fq_; asm volatile("" : "+v"(fr), "+v"(fq));
    typedef const __attribute__((address_space(4))) Params* KP;
    KP kp = (KP)__builtin_amdgcn_kernarg_segment_ptr();
    asm volatile("" : "+s"(kp));
    const float* gains = kp->gains; float* xout = kp->out; const float* xin_p = kp->xp; const float* xin_s = kp->xs;
    unsigned char* w2 = kp->ws;
    const float* gpost = gains + gi * DM; const float* gpre = gains + (gi + 1) * DM;
    const bool fin = gi == 11;
    const int lane = fq * 16 + fr, tid = (wr * 4 + wc) * 64 + lane;
    LAS float* part = (LAS float*)(lds + 131072);
    LAS float* stat = (LAS float*)(lds + 131072 + 16384);
    float* xch = (float*)(w2 + OFF_XCH); unsigned* cnt = (unsigned*)(w2 + OFF_CNT) + ph * 128 + u.pm;
    const int colw = u.pn * 256 + wc * 32 + 8 * fq;
    const int row0u = rb + u.pm * 256;
    const float* xsrc = row0u < TH ? xin_p : xin_s - (size_t)TH * DM;
    bf16_t* X = (bf16_t*)(w2 + OFF_HF);
    f32x4 gp[2][2];
#pragma unroll
    for (int bj = 0; bj < 2; ++bj) { gp[bj][0] = *(const f32x4*)(gpost + colw + bj * 128); gp[bj][1] = *(const f32x4*)(gpost + colw + bj * 128 + 4); }
#pragma unroll
    for (int ab = 0; ab < 4; ++ab) {
      const int ai = ab >> 1;
      f32x4 xb[4][4];
#pragma unroll
      for (int m = 2 * (ab & 1); m < 2 * (ab & 1) + 2; ++m) {
        const unsigned xo = (unsigned)((rb + u.pm * 256 + ai * 128 + wr * 64 + m * 16 + fr) * DM + colw) * 4u;
        if (first) {
#pragma unroll
          for (int q = 0; q < 4; ++q) xb[m][q] = ldf4(xsrc, xo + (unsigned)((q >> 1) * 512 + 16 * (q & 1)));
        } else {
#pragma unroll
          for (int bj = 0; bj < 2; ++bj) {
            const u32x4 wv = *(const u32x4*)((const char*)X + ((xo >> 1) + (unsigned)(bj * 256)));
            xb[m][bj * 2] = (f32x4){bf_lo(wv.x), bf_hi(wv.x), bf_lo(wv.y), bf_hi(wv.y)}; xb[m][bj * 2 + 1] = (f32x4){bf_lo(wv.z), bf_hi(wv.z), bf_lo(wv.w), bf_hi(wv.w)};
          }
        }
      }
#pragma unroll
      for (int m = 2 * (ab & 1); m < 2 * (ab & 1) + 2; ++m) {
        const int rl = ai * 128 + wr * 64 + m * 16 + fr;
        f32x4 sv = (f32x4){0.f, 0.f, 0.f, 0.f};
#pragma unroll
        for (int bj = 0; bj < 2; ++bj)
#pragma unroll
          for (int n = 0; n < 2; ++n) {
            const f32x4 x = xb[m][bj * 2 + n]; const f32x4 f = acc[ai][bj][m][n]; const f32x4 fp = f * gp[bj][n];
#pragma unroll
            for (int j = 0; j < 4; ++j) { sv[0] += f[j] * f[j]; sv[1] += x[j] * x[j]; sv[2] += x[j] * fp[j]; sv[3] += fp[j] * fp[j]; }
          }
#pragma unroll
        for (int e = 0; e < 4; ++e) { sv[e] += shx(sv[e], lane, 16); sv[e] += shx(sv[e], lane, 32); }
        if (fq == 0) *(LAS f32x4*)(part + (rl * 4 + wc) * 4) = sv;
      }
      __builtin_amdgcn_sched_barrier(0);
    }
    __syncthreads();
    if (tid < 256) {
      const f32x4 a = *(const LAS f32x4*)(part + (tid * 4 + 0) * 4), b = *(const LAS f32x4*)(part + (tid * 4 + 1) * 4), c = *(const LAS f32x4*)(part + (tid * 4 + 2) * 4), d = *(const LAS f32x4*)(part + (tid * 4 + 3) * 4);
      const f32x4 t = a + b + c + d;
      const unsigned so = (unsigned)((u.pm * 4 + u.pn) * 256 + tid) * 16u;
#pragma unroll
      for (int e = 0; e < 4; ++e) __hip_atomic_store((float*)((char*)xch + (so + 4u * e)), t[e], __ATOMIC_RELAXED, __HIP_MEMORY_SCOPE_AGENT);
    }
    asm volatile("s_waitcnt vmcnt(0)" ::: "memory");
    __syncthreads();
    if (tid == 0) {
      (void)__hip_atomic_fetch_add(cnt, 1u, __ATOMIC_RELAXED, __HIP_MEMORY_SCOPE_AGENT);
      unsigned spins = 0;
      while (__hip_atomic_load(cnt, __ATOMIC_RELAXED, __HIP_MEMORY_SCOPE_AGENT) < 4u * (unsigned)(1 + ((rep == 1 && ph < PROBE_P) ? 1 : 0))) { __builtin_amdgcn_s_sleep(1); if (++spins > (1u << 22)) break; }
    }
    __syncthreads();
    if (tid < 256) {
      f32x4 t = (f32x4){0.f, 0.f, 0.f, 0.f};
#pragma unroll
      for (int q = 0; q < 4; ++q) {
        const unsigned so = (unsigned)((u.pm * 4 + q) * 256 + tid) * 16u;
#pragma unroll
        for (int e = 0; e < 4; ++e) t[e] += __hip_atomic_load((const float*)((const char*)xch + (so + 4u * e)), __ATOMIC_RELAXED, __HIP_MEMORY_SCOPE_AGENT);
      }
      int gi2 = gi; asm volatile("" : "+s"(gi2));
      const float scale = (gi2 == 3 || gi2 == 9) ? 1.0f : 0.5f;
      const float al = scale * __builtin_amdgcn_rsqf(t[0] * (1.0f / 1024.0f) + 1e-6f);
      const float sx = t[1] + 2.0f * al * t[2] + al * al * t[3];
      stat[tid * 2] = al; stat[tid * 2 + 1] = __builtin_amdgcn_rsqf(fmaxf(sx, 0.f) * (1.0f / 1024.0f) + 1e-6f);
    }
    __syncthreads();
    bf16_t* hfp = (bf16_t*)xout;
#pragma unroll
    for (int ab = 0; ab < 4; ++ab) {
      const int ai = ab >> 1;
      f32x4 xb[4][4]; f32x4 gq[4];
#pragma unroll
      for (int m = 2 * (ab & 1); m < 2 * (ab & 1) + 2; ++m) {
        const unsigned xo = (unsigned)((rb + u.pm * 256 + ai * 128 + wr * 64 + m * 16 + fr) * DM + colw) * 4u;
        if (first) {
#pragma unroll
          for (int q = 0; q < 4; ++q) xb[m][q] = ldf4(xsrc, xo + (unsigned)((q >> 1) * 512 + 16 * (q & 1)));
        } else {
#pragma unroll
          for (int bj = 0; bj < 2; ++bj) {
            const u32x4 wv = *(const u32x4*)((const char*)X + ((xo >> 1) + (unsigned)(bj * 256)));
            xb[m][bj * 2] = (f32x4){bf_lo(wv.x), bf_hi(wv.x), bf_lo(wv.y), bf_hi(wv.y)}; xb[m][bj * 2 + 1] = (f32x4){bf_lo(wv.z), bf_hi(wv.z), bf_lo(wv.w), bf_hi(wv.w)};
          }
        }
      }
#pragma unroll
      for (int q = 0; q < 4; ++q) gq[q] = ldf4(gpre, (unsigned)(colw + (q >> 1) * 128 + 4 * (q & 1)) * 4u);
#pragma unroll
      for (int m = 2 * (ab & 1); m < 2 * (ab & 1) + 2; ++m) {
        const int rl = ai * 128 + wr * 64 + m * 16 + fr; const int row = rb + u.pm * 256 + rl;
        const unsigned xo = (unsigned)(row * DM + colw) * 4u;
        const float al = stat[rl * 2], rs2 = stat[rl * 2 + 1];
#pragma unroll
        for (int bj = 0; bj < 2; ++bj) {
          f32x4 xn[2];
#pragma unroll
          for (int n = 0; n < 2; ++n) xn[n] = xb[m][bj * 2 + n] + (acc[ai][bj][m][n] * gp[bj][n]) * al;
          if (fin) {
            *(f32x4*)((char*)xout + (xo + (unsigned)(bj * 512))) = xn[0]; *(f32x4*)((char*)xout + (xo + (unsigned)(bj * 512 + 16))) = xn[1];
          } else st16(X, (xo >> 1) + (unsigned)(bj * 256), pk8(xn[0], xn[1]));
          if (!fin) st16(hfp, (unsigned)(row * DM + colw + bj * 128) * 2u, pk8(xn[0] * gq[bj * 2] * rs2, xn[1] * gq[bj * 2 + 1] * rs2));
        }
      }
      __builtin_amdgcn_sched_barrier(0);
    }
  }
};
struct PhQkv {
  unsigned char* ws; const char* H; int K;
  DI bool next(int i, Unit& u) const { int L = i * (int)gridDim.x + (int)blockIdx.x; if (L >= 768) return false;
    const char* W = (const char*)(ws + OFF_MIX_IN);
    if (L < 640) { tile_remap(L, 128, 5, u.pm, u.pn); u.seg = 0; u.a = H + (size_t)u.pm * (512 * 1024); u.b = W + (size_t)u.pn * (512 * 1024); }
    else { L -= 640; u.pm = 0; u.pn = L; u.seg = 1; u.a = W + (size_t)1280 * 2048; u.b = H + (size_t)u.pn * (512 * 1024); }
    return true; }
  DI void epi(const Acc& acc, const Unit& u, int wr, int wc, int fr, int fq, LAS unsigned char* lds) const {
    unsigned char* w2 = ws; asm volatile("" : "+s"(w2));
    bf16_t* q = (bf16_t*)(w2 + OFF_BIG); bf16_t* k = (bf16_t*)(w2 + OFF_BIG + 64 * MiB); bf16_t* vT = (bf16_t*)(w2 + OFF_BIG + 80 * MiB);
    const float* cosA = (const float*)(w2 + OFF_COSA); const float* sinA = (const float*)(w2 + OFF_SINA);
    if (u.seg == 0) {
      const bool isq = u.pn < 4; const float sc = isq ? 0.125f : 1.0f;
      bf16_t* base = isq ? q + u.pn * 256 : k; const int ld = isq ? 1024 : 256;
      const bool rot = (wc & 1) == 0;
#pragma unroll
      for (int ai = 0; ai < 2; ++ai)
#pragma unroll
        for (int m = 0; m < 4; ++m) {
          const int row = u.pm * 256 + ai * 128 + wr * 64 + m * 16 + fr; const int pos = tok_pos(row);
#pragma unroll
          for (int bj = 0; bj < 2; ++bj) {
            f32x4 v0 = acc[ai][bj][m][0], v1 = acc[ai][bj][m][1];
            if (rot) {
              f32x4 o0, o1;
#pragma unroll
              for (int j = 0; j < 4; ++j) { o0[j] = shx(v0[j], fq * 16 + fr, 16); o1[j] = shx(v1[j], fq * 16 + fr, 16); }
              if (fq < 2) {
                const f32x4 c0 = ldf4(cosA, (unsigned)pos * 32u), c1 = ldf4(cosA, (unsigned)pos * 32u + 16u);
                f32x4 s0 = ldf4(sinA, (unsigned)pos * 32u), s1 = ldf4(sinA, (unsigned)pos * 32u + 16u);
                if (fq == 0) { s0 = -s0; s1 = -s1; }
                v0 = v0 * c0 + o0 * s0; v1 = v1 * c1 + o1 * s1;
              }
            }
            v0 *= sc; v1 *= sc;
            {
              const int hl = bj * 2 + (wc >> 1), head = isq ? u.pn * 4 + hl : hl, d0 = (wc & 1) * 32 + 8 * fq;
              st16(isq ? q : k, (unsigned)((((head * 1024 + (row >> 5)) * 4 + (d0 >> 4)) * 64 + ((d0 >> 3) & 1) * 32 + (row & 31)) * 16), pk8(v0, v1)); }
            __builtin_amdgcn_sched_barrier(0);
          }
        }
    } else {
#pragma unroll
      for (int ai = 0; ai < 2; ++ai)
#pragma unroll
        for (int m = 0; m < 4; ++m) {
          const int row = ai * 128 + wr * 64 + m * 16 + fr;
#pragma unroll
          for (int bj = 0; bj < 2; ++bj)
          {
            const int tl = u.pn * 256 + bj * 128 + wc * 32 + 8 * fq, ko = tl & 31;
            const unsigned bo = (unsigned)((((((row >> 6) * 1024 + (tl >> 5)) * 2 + ((row & 63) >> 5)) * 2 + (ko >> 4)) * 64 + (row & 31)) * 16 + ((ko >> 3) & 1) * 8);
            const u32x4 w = pk8(acc[ai][bj][m][0], acc[ai][bj][m][1]);
            *(u32x2*)((char*)vT + bo) = (u32x2){w.x, w.y};
            *(u32x2*)((char*)vT + bo + 512u) = (u32x2){w.z, w.w}; }
        }
    }
  }
};
template <int K> DI void tstage8(float (&v)[8], int lane) {
  const bool up = (lane & K) != 0;
#pragma unroll
  for (int j = 0; j < 8; ++j) {
    if ((j & K) == 0) {
      const float send = up ? v[j] : v[j | K];
      const float recv = shx(send, lane, K);
      if (up) v[j] = recv; else v[j | K] = recv;
    }
  }
}
DI void transpose8(float (&v)[8], int lane) { tstage8<4>(v, lane); tstage8<2>(v, lane); tstage8<1>(v, lane); }
struct PhRetIn {
  unsigned char* ws; const char* H; int rb; int K;
  DI bool next(int i, Unit& u) const { int L = i * (int)gridDim.x + (int)blockIdx.x; if (L >= 1024) return false;
    const char* W = (const char*)(ws + OFF_MIX_IN);
    if (L < 512) { tile_remap(L, 64, 8, u.pm, u.pn); u.seg = 0; u.a = H + (size_t)(rb + u.pm * 256) * 2048; u.b = W + (size_t)u.pn * (512 * 1024); }
    else { L -= 512; tile_remap(L, 8, 64, u.pm, u.pn); u.pm += 4; u.seg = 1; u.a = W + (size_t)(1024 + u.pm * 256) * 2048; u.b = H + (size_t)(rb + u.pn * 256) * 2048; }
    return true; }
  DI void epi(const Acc& acc, const Unit& u, int wr, int wc, int fr, int fq, LAS unsigned char* lds) const {
    unsigned char* w2 = ws; asm volatile("" : "+s"(w2));
    bf16_t* qr = (bf16_t*)(w2 + OFF_BIG); bf16_t* kr = (bf16_t*)(w2 + OFF_BIG + 32 * MiB); bf16_t* kT = (bf16_t*)(w2 + OFF_BIG + 64 * MiB); bf16_t* vT = (bf16_t*)(w2 + OFF_BIG + 96 * MiB);
    const float* cosR = (const float*)(w2 + OFF_COSR); const float* sinR = (const float*)(w2 + OFF_SINR); const float* cosRT = (const float*)(w2 + OFF_COSRT); const float* sinRT = (const float*)(w2 + OFF_SINRT);
    if (u.seg == 0) {
      const bool isq = u.pn < 4; const float sc = isq ? 1.0f : 0.0625f;
      bf16_t* base = isq ? qr : kr; const int hd = isq ? u.pn : u.pn - 4;
      const int d0 = wc * 32 + 8 * fq;
      const unsigned fo = (unsigned)hd * 65536u + (unsigned)(d0 >> 4) * 1024u + (unsigned)((d0 >> 3) & 1) * 512u;
#pragma unroll
      for (int ai = 0; ai < 2; ++ai)
#pragma unroll
        for (int m = 0; m < 4; ++m) {
          const int rl = u.pm * 256 + ai * 128 + wr * 64 + m * 16 + fr; const int pos = tok_pos(rb + rl);
          const unsigned to = (unsigned)(pos * 128 + d0) * 4u; const f32x4 c0 = ldf4(cosR, to), c1 = ldf4(cosR, to + 16u);
          const f32x4 s0 = ldf4(sinR, to), s1 = ldf4(sinR, to + 16u);
          const f32x4 a0 = acc[ai][0][m][0], a1 = acc[ai][0][m][1], b0 = acc[ai][1][m][0], b1 = acc[ai][1][m][1];
          const f32x4 x0 = (a0 * c0 - b0 * s0) * sc, x1 = (a1 * c1 - b1 * s1) * sc, y0 = (b0 * c0 + a0 * s0) * sc, y1 = (b1 * c1 + a1 * s1) * sc;
          const unsigned ro = fo + (unsigned)(rl >> 7) * 262144u + (unsigned)((rl >> 5) & 3) * 16384u + (unsigned)(rl & 31) * 16u;
          st16(base, ro, pk8(x0, x1));
          st16(base, ro + 8192u, pk8(y0, y1));
          if (!isq) {
            float vx[8] = {x0[0], x0[1], x0[2], x0[3], x1[0], x1[1], x1[2], x1[3]}, vy[8] = {y0[0], y0[1], y0[2], y0[3], y1[0], y1[1], y1[2], y1[3]};
            const int lane = fq * 16 + fr;
            transpose8(vx, lane); transpose8(vy, lane);
            const int tl = rl & ~7, dk = d0 + (fr & 7);
            const unsigned kro = (unsigned)((tl >> 7) * 4 + hd) * 65536u + (unsigned)(dk >> 5) * 8192u + (unsigned)((tl & 127) >> 4) * 1024u + (unsigned)((tl >> 3) & 1) * 512u + (unsigned)(dk & 31) * 16u;
            st16(kT, kro, pk8((f32x4){vx[0], vx[1], vx[2], vx[3]}, (f32x4){vx[4], vx[5], vx[6], vx[7]}));
            st16(kT, kro + 4u * 8192u, pk8((f32x4){vy[0], vy[1], vy[2], vy[3]}, (f32x4){vy[4], vy[5], vy[6], vy[7]}));
          }
          __builtin_amdgcn_sched_barrier(0);
        }
    } else if (u.pm < 4) {
      const int tl0 = u.pn * 256 + wc * 32 + 8 * fq;
#pragma unroll
      for (int m = 0; m < 4; ++m) {
        const int d = wr * 64 + m * 16 + fr;
#pragma unroll
        for (int bj = 0; bj < 2; ++bj) {
          const int tl = tl0 + bj * 128; const int pos = tok_pos(rb + tl);
          const unsigned to = (unsigned)(d * 4096 + pos) * 4u; const f32x4 c0 = ldf4(cosRT, to), c1 = ldf4(cosRT, to + 16u);
          const f32x4 s0 = ldf4(sinRT, to), s1 = ldf4(sinRT, to + 16u);
          const f32x4 a0 = acc[0][bj][m][0], a1 = acc[0][bj][m][1], b0 = acc[1][bj][m][0], b1 = acc[1][bj][m][1];
          const f32x4 x0 = (a0 * c0 - b0 * s0) * 0.0625f, x1 = (a1 * c1 - b1 * s1) * 0.0625f, y0 = (b0 * c0 + a0 * s0) * 0.0625f, y1 = (b1 * c1 + a1 * s1) * 0.0625f;
          const unsigned ro = (unsigned)((tl >> 7) * 4 + u.pm) * 65536u + (unsigned)(d >> 5) * 8192u + (unsigned)((tl & 127) >> 4) * 1024u + (unsigned)((tl >> 3) & 1) * 512u + (unsigned)(d & 31) * 16u;
          st16(kT, ro, pk8(x0, x1));
          st16(kT, ro + 4u * 8192u, pk8(y0, y1));
          __builtin_amdgcn_sched_barrier(0);
        }
      }
    } else {
#pragma unroll
      for (int ai = 0; ai < 2; ++ai)
#pragma unroll
        for (int m = 0; m < 4; ++m) {
          const int row = (u.pm - 4) * 256 + ai * 128 + wr * 64 + m * 16 + fr;
#pragma unroll
          for (int bj = 0; bj < 2; ++bj) {
            const int tl = u.pn * 256 + bj * 128 + wc * 32 + 8 * fq;
            const unsigned ro = (unsigned)((tl >> 7) * 4 + (row >> 9)) * 131072u + (unsigned)((row & 511) >> 5) * 8192u + (unsigned)((tl & 127) >> 4) * 1024u + (unsigned)((tl >> 3) & 1) * 512u + (unsigned)(row & 31) * 16u;
            st16(vT, ro, pk8(acc[ai][bj][m][0], acc[ai][bj][m][1]));
          }
        }
    }
  }
};
struct PhGate {
  const char* H; const char* W; bf16_t* y; const float* ss; int rb; int K;
  DI bool next(int i, Unit& u) const { const int L = i * (int)gridDim.x + (int)blockIdx.x; if (L >= 512) return false; tile_remap(L, 64, 8, u.pm, u.pn); u.seg = 0;
    u.a = H + (size_t)(rb + u.pm * 256) * 2048; u.b = W + (size_t)(4096 + u.pn * 256) * 2048; return true; }
  DI void epi(const Acc& acc, const Unit& u, int wr, int wc, int fr, int fq, LAS unsigned char* lds) const {
    const int hd = u.pn >> 1;
#pragma unroll
    for (int ai = 0; ai < 2; ++ai) {
      u32x4 yv[4][2]; f32x4 p0[4];
#pragma unroll
      for (int m = 0; m < 4; ++m) {
        const int rl = u.pm * 256 + ai * 128 + wr * 64 + m * 16 + fr;
        p0[m] = ldf4(ss, (unsigned)(rl * 4 + hd) * 64u);
#pragma unroll
        for (int bj = 0; bj < 2; ++bj) yv[m][bj] = *(const u32x4*)((const char*)y + (unsigned)(rl * 2048 + u.pn * 256 + bj * 128 + wc * 32 + 8 * fq) * 2u);
      }
#pragma unroll
      for (int m = 0; m < 4; ++m) {
        const int rl = u.pm * 256 + ai * 128 + wr * 64 + m * 16 + fr;
        const float rs = __builtin_amdgcn_rsqf((p0[m][0] + p0[m][1]) * (1.0f / 512.0f) + 1e-6f);
#pragma unroll
        for (int bj = 0; bj < 2; ++bj) {
          const unsigned yo = (unsigned)(rl * 2048 + u.pn * 256 + bj * 128 + wc * 32 + 8 * fq) * 2u;
          const u32x4 w4 = yv[m][bj];
          f32x4 v0, v1;
          v0[0] = silu_f(acc[ai][bj][m][0][0]) * bf_lo(w4.x) * rs; v0[1] = silu_f(acc[ai][bj][m][0][1]) * bf_hi(w4.x) * rs;
          v0[2] = silu_f(acc[ai][bj][m][0][2]) * bf_lo(w4.y) * rs; v0[3] = silu_f(acc[ai][bj][m][0][3]) * bf_hi(w4.y) * rs;
          v1[0] = silu_f(acc[ai][bj][m][1][0]) * bf_lo(w4.z) * rs; v1[1] = silu_f(acc[ai][bj][m][1][1]) * bf_hi(w4.z) * rs;
          v1[2] = silu_f(acc[ai][bj][m][1][2]) * bf_lo(w4.w) * rs; v1[3] = silu_f(acc[ai][bj][m][1][3]) * bf_hi(w4.w) * rs;
          st16(y, yo, pk8(v0, v1));
        }
      }
      __builtin_amdgcn_sched_barrier(0);
    }
  }
};

DI void convert_mat(LAS float* tile, const float* src, int K, int N, bf16_t* dst, int ffn_in_mode, int wave_s) {
  const int tid = tid_fresh(wave_s), tk = K >> 6, tn = N >> 6;
  for (int t = blockIdx.x; t < tk * tn; t += gridDim.x) {
    const int kb = t % tk, nb = t / tk;
#pragma unroll
    for (int i = 0; i < 2; ++i) {
      const int r = (tid >> 4) + 32 * i, c = (tid & 15) * 4;
      const f32x4 v = *(const f32x4*)(src + (size_t)(kb * 64 + r) * N + nb * 64 + c);
      tile[r * 65 + c] = v[0]; tile[r * 65 + c + 1] = v[1]; tile[r * 65 + c + 2] = v[2]; tile[r * 65 + c + 3] = v[3];
    }
    __syncthreads();
    {
      const int n = tid >> 3, k0 = (tid & 7) * 8;
      float v[8];
#pragma unroll
      for (int j = 0; j < 8; ++j) v[j] = tile[(k0 + j) * 65 + n];
      int no = nb * 64 + n;
      if (ffn_in_mode) { const int half = no >= DFF ? 1 : 0; const int np = no - half * DFF; no = 256 * (np >> 7) + 128 * half + (np & 127); }
      u32x4 w; w.x = cvt_pk_bf16(v[0], v[1]); w.y = cvt_pk_bf16(v[2], v[3]); w.z = cvt_pk_bf16(v[4], v[5]); w.w = cvt_pk_bf16(v[6], v[7]);
      *(u32x4*)(dst + (size_t)no * K + kb * 64 + k0) = w;
    }
    __syncthreads();
  }
}
DI void convert_layer(LAS unsigned char* lds, const Params& p, int layer) {
  LAS float* tile = (LAS float*)lds;
  bf16_t* w = (bf16_t*)p.ws;
  for (int i = 0; i < 2; ++i) {
    convert_mat(tile, p.ffn_in + (size_t)(layer * 2 + i) * DM * 2 * DFF, DM, 2 * DFF, (bf16_t*)(p.ws + i * SZ_FFN_IN), 1, p.wave_s);
    convert_mat(tile, p.ffn_out + (size_t)(layer * 2 + i) * DFF * DM, DFF, DM, (bf16_t*)(p.ws + OFF_FFN_OUT0 + i * SZ_FFN_OUT), 0, p.wave_s);
  }
  if (layer == 0) {
    convert_mat(tile, p.wqkv, DM, 1536, (bf16_t*)(p.ws + OFF_MIX_IN), 0, p.wave_s);
    convert_mat(tile, p.wao, DM, DM, (bf16_t*)(p.ws + OFF_MIX_OUT), 0, p.wave_s);
  } else {
    convert_mat(tile, p.wret_in, DM, 6144, (bf16_t*)(p.ws + OFF_MIX_IN), 0, p.wave_s);
    convert_mat(tile, p.wret_o, 2048, DM, (bf16_t*)(p.ws + OFF_MIX_OUT), 0, p.wave_s);
  }
  (void)w;
}
DI void build_tables(const Params& p) {
  float* cosA = (float*)(p.ws + OFF_COSA); float* sinA = (float*)(p.ws + OFF_SINA);
  float* cosR = (float*)(p.ws + OFF_COSR); float* sinR = (float*)(p.ws + OFF_SINR);
  float* cosRT = (float*)(p.ws + OFF_COSRT); float* sinRT = (float*)(p.ws + OFF_SINRT);
  const int gt = blockIdx.x * 512 + tid_fresh(p.wave_s), gn = gridDim.x * 512;
  for (int e = gt; e < 4096 * 136; e += gn) {
    int pos, i; float invf;
    const bool isA = e < 4096 * 8;
    if (isA) { pos = e >> 3; i = e & 7; invf = exp2f(-(float)i * (18.931568569324174f / 8.0f)); }
    else { const int e2 = e - 4096 * 8; pos = e2 >> 7; i = e2 & 127; invf = exp2f(-(float)i * (13.287712379549449f / 128.0f)); }
    const double rev = (double)pos * (double)invf * 0.15915494309189535;
    const float fr = (float)(rev - rint(rev));
    const float c = __builtin_amdgcn_cosf(fr), s = __builtin_amdgcn_sinf(fr);
    if (isA) { cosA[e] = c; sinA[e] = s; }
    else { cosR[pos * 128 + i] = c; sinR[pos * 128 + i] = s; cosRT[i * 4096 + pos] = c; sinRT[i * 4096 + pos] = s; }
  }
}

DI void load_bf8(const bf16_t* p, float* v) { const u32x4 w = *(const u32x4*)p; v[0] = bf_lo(w.x); v[1] = bf_hi(w.x); v[2] = bf_lo(w.y); v[3] = bf_hi(w.y); v[4] = bf_lo(w.z); v[5] = bf_hi(w.z); v[6] = bf_lo(w.w); v[7] = bf_hi(w.w); }
DI void load_f8(const float* p, float* v) { const f32x4 a = *(const f32x4*)p, b = *(const f32x4*)(p + 4); v[0] = a[0]; v[1] = a[1]; v[2] = a[2]; v[3] = a[3]; v[4] = b[0]; v[5] = b[1]; v[6] = b[2]; v[7] = b[3]; }
DI void store_f8(float* p, const float* v) { *(f32x4*)p = (f32x4){v[0], v[1], v[2], v[3]}; *(f32x4*)(p + 4) = (f32x4){v[4], v[5], v[6], v[7]}; }
DI void store_bf8(bf16_t* p, const float* v) { u32x4 w; w.x = cvt_pk_bf16(v[0], v[1]); w.y = cvt_pk_bf16(v[2], v[3]); w.z = cvt_pk_bf16(v[4], v[5]); w.w = cvt_pk_bf16(v[6], v[7]); *(u32x4*)p = w; }

template <int MODE, bool FIRST, bool DRY = false>
DI void norm_phase(const Params& p, const float* gpost, float scale, const float* gpre) {
  bf16_t* hf = (bf16_t*)p.out;
  const int tidn = tid_fresh(p.wave_s); const int wid = tidn >> 6, lane = tidn & 63;
  for (int row = blockIdx.x * 8 + wid; row < T; row += gridDim.x * 8) {
    const float* xsrc = (MODE == 0 || FIRST) ? (row < TH ? p.xp + (size_t)row * DM : p.xs + (size_t)(row - TH) * DM) : p.out + (size_t)row * DM;
    float x[16];
    load_f8(xsrc + lane * 8, x); load_f8(xsrc + 512 + lane * 8, x + 8);
    if (MODE != 0) {
      float f[16], gp[16];
      load_bf8(hf + (size_t)row * DM + lane * 8, f); load_bf8(hf + (size_t)row * DM + 512 + lane * 8, f + 8);
      load_f8(gpost + lane * 8, gp); load_f8(gpost + 512 + lane * 8, gp + 8);
      float ss = 0.f;
#pragma unroll
      for (int j = 0; j < 16; ++j) ss += f[j] * f[j];
      ss = wave_sum(ss, lane);
      const float rs = __builtin_amdgcn_rsqf(ss * (1.0f / 1024.0f) + 1e-6f) * scale;
#pragma unroll
      for (int j = 0; j < 16; ++j) x[j] += f[j] * rs * gp[j];
      if (!DRY || rs == 12345.678f) { store_f8(p.out + (size_t)row * DM + lane * 8, x); store_f8(p.out + (size_t)row * DM + 512 + lane * 8, x + 8); }
    }
    if (MODE != 2) {
      float g[16];
      load_f8(gpre + lane * 8, g); load_f8(gpre + 512 + lane * 8, g + 8);
      float ss = 0.f;
#pragma unroll
      for (int j = 0; j < 16; ++j) ss += x[j] * x[j];
      ss = wave_sum(ss, lane);
      const float rs = __builtin_amdgcn_rsqf(ss * (1.0f / 1024.0f) + 1e-6f);
      float h[16];
#pragma unroll
      for (int j = 0; j < 16; ++j) h[j] = x[j] * rs * g[j];
      if (!DRY || rs == 12345.678f) { store_bf8(hf + (size_t)row * DM + lane * 8, h); store_bf8(hf + (size_t)row * DM + 512 + lane * 8, h + 8); }
    }
  }
}

DI void attn_phase(const Params& p) {
  const bf16_t* q = (const bf16_t*)(p.ws + OFF_BIG); const bf16_t* k = (const bf16_t*)(p.ws + OFF_BIG + 64 * MiB);
  const bf16_t* vT = (const bf16_t*)(p.ws + OFF_BIG + 80 * MiB); bf16_t* o = (bf16_t*)(p.ws + OFF_BIG + 96 * MiB);
  const int tida = tid_fresh(p.wave_s); const int w = tida >> 6, lane = tida & 63, r = lane & 31, h = lane >> 5;
  for (int item = blockIdx.x; item < 1024; item += gridDim.x) {
    const int g = item & 3, qb = item >> 2;
    const int t0 = qb * 128 + (w & 3) * 32, head0 = g * 4 + 2 * (w >> 2);
    const int s0 = t0 < TH ? (t0 & ~2047) : (t0 & ~4095), s1 = s0 + (t0 < TH ? 2048 : 4096);
    bf16x8 qf[2][4];
    float mrun[2], lrun[2];
    f32x16 o0[2], o1[2];
#pragma unroll
    for (int hh = 0; hh < 2; ++hh) {
#pragma unroll
      for (int s = 0; s < 4; ++s) qf[hh][s] = ldg16(q, (unsigned)((((head0 + hh) * 1024 + (t0 >> 5)) * 4 + s) * 64 + lane) * 16u);
      mrun[hh] = p.sink[head0 + hh]; lrun[hh] = 1.0f;
#pragma unroll
      for (int i = 0; i < 16; ++i) { o0[hh][i] = 0.f; o1[hh][i] = 0.f; }
    }
    const int ka_ = s0 - t0 + 128, kb_ = (s1 - t0 + 128) >> 5;
    const int kt_lo = ka_ > 0 ? (ka_ >> 5) : 0, kt_hi = kb_ < 9 ? kb_ : 9;
    bf16x8 kf[4], vf[4];
    {
      const int ks0 = t0 - 128 + 32 * kt_lo;
      const unsigned kofs0 = (unsigned)(((g * 1024 + (ks0 >> 5)) * 4) * 64 + lane) * 16u;
#pragma unroll
      for (int st = 0; st < 4; ++st) { kf[st] = ldg16(k, kofs0 + 1024u * st); vf[st] = ldg16(vT, kofs0 + 1024u * st); }
    }
    for (int kt = kt_lo; kt < kt_hi; ++kt) {
      const int ks = t0 - 128 + 32 * kt;
      const int ksn = kt + 1 < kt_hi ? ks + 32 : ks;
      const unsigned nofs = (unsigned)(((g * 1024 + (ksn >> 5)) * 4) * 64 + lane) * 16u;
      f32x16 s[2];
#pragma unroll
      for (int hh = 0; hh < 2; ++hh) {
#pragma unroll
        for (int i = 0; i < 16; ++i) s[hh][i] = 0.f;
#pragma unroll
        for (int st = 0; st < 4; ++st) s[hh] = MFMA32(kf[st], qf[hh][st], s[hh]);
      }
      asm volatile("" : "+v"(s[0]), "+v"(s[1]) :: "memory");
#pragma unroll
      for (int st = 0; st < 4; ++st) kf[st] = ldg16(k, nofs + 1024u * st);
      bf16x8 pb[2][2];
#pragma unroll
      for (int hh = 0; hh < 2; ++hh) {
        float mx = -INFINITY;
        if (kt == 0 || kt == 8) {
#pragma unroll
          for (int i = 0; i < 16; ++i) {
            const int d = (ks + (i & 3) + 8 * (i >> 2) + 4 * h) - (t0 + r);
            const bool valid = d >= -128 && d <= 128;
            s[hh][i] = valid ? s[hh][i] : -INFINITY; mx = fmaxf(mx, s[hh][i]);
          }
        } else {
#pragma unroll
          for (int i = 0; i < 16; ++i) mx = fmaxf(mx, s[hh][i]);
        }
        mx = fmaxf(mx, shx(mx, lane, 32));
        const float mnew = fmaxf(mrun[hh], mx);
        const float alpha = __expf(mrun[hh] - mnew);
        float psum = 0.f;
#pragma unroll
        for (int i = 0; i < 16; ++i) { const float pe = __expf(s[hh][i] - mnew); s[hh][i] = pe; psum += pe; }
        psum += shx(psum, lane, 32);
        lrun[hh] = lrun[hh] * alpha + psum; mrun[hh] = mnew;
#pragma unroll
        for (int i = 0; i < 16; ++i) { o0[hh][i] *= alpha; o1[hh][i] *= alpha; }
        pb[hh][0] = pack8(s[hh], 0); pb[hh][1] = pack8(s[hh], 1);
      }
#pragma unroll
      for (int hh = 0; hh < 2; ++hh) {
        o0[hh] = MFMA32(vf[0], pb[hh][0], o0[hh]);
        o0[hh] = MFMA32(vf[1], pb[hh][1], o0[hh]);
        o1[hh] = MFMA32(vf[2], pb[hh][0], o1[hh]);
        o1[hh] = MFMA32(vf[3], pb[hh][1], o1[hh]);
      }
      asm volatile("" : "+v"(o0[0]), "+v"(o1[0]), "+v"(o0[1]), "+v"(o1[1]) :: "memory");
#pragma unroll
      for (int st = 0; st < 4; ++st) vf[st] = ldg16(vT, nofs + 1024u * st);
    }
#pragma unroll
    for (int hh = 0; hh < 2; ++hh) {
      const float inv = 1.0f / lrun[hh];
      bf16_t* op = o + (size_t)(t0 + r) * 1024 + (head0 + hh) * 64 + 4 * h;
#pragma unroll
      for (int gq = 0; gq < 4; ++gq) {
        u32x2 a, b;
        a.x = cvt_pk_bf16(o0[hh][4 * gq] * inv, o0[hh][4 * gq + 1] * inv); a.y = cvt_pk_bf16(o0[hh][4 * gq + 2] * inv, o0[hh][4 * gq + 3] * inv);
        b.x = cvt_pk_bf16(o1[hh][4 * gq] * inv, o1[hh][4 * gq + 1] * inv); b.y = cvt_pk_bf16(o1[hh][4 * gq + 2] * inv, o1[hh][4 * gq + 3] * inv);
        *(u32x2*)(op + 8 * gq) = a; *(u32x2*)(op + 32 + 8 * gq) = b;
      }
    }
  }
}

DI float log2_gamma(float x) { return -__builtin_amdgcn_logf(1.0f + __builtin_amdgcn_exp2f(-1.4426950408889634f * x)); }
#define EX2(x) __builtin_amdgcn_exp2f(x)
DI bf16x8 scale_frag(bf16x8 a, float a0, float a1, int jbase) {
  const u32x4 w = __builtin_bit_cast(u32x4, a); u32x4 o;
  const float b = a0 + a1 * (float)jbase;
  o.x = rne_pk(bf_lo(w.x) * EX2(b), bf_hi(w.x) * EX2(b + a1));
  o.y = rne_pk(bf_lo(w.y) * EX2(b + 2.f * a1), bf_hi(w.y) * EX2(b + 3.f * a1));
  o.z = rne_pk(bf_lo(w.z) * EX2(b + 4.f * a1), bf_hi(w.z) * EX2(b + 5.f * a1));
  o.w = rne_pk(bf_lo(w.w) * EX2(b + 6.f * a1), bf_hi(w.w) * EX2(b + 7.f * a1));
  return __builtin_bit_cast(bf16x8, o);
}
DI void lds_barrier() {
  asm volatile("s_waitcnt lgkmcnt(0)" ::: "memory"); __builtin_amdgcn_s_barrier(); asm volatile("" ::: "memory"); }
DI bf16x8 scale_tab(bf16x8 v, const LAS float* d) {
  const f32x4 d0 = *(const LAS f32x4*)d, d1 = *(const LAS f32x4*)(d + 4);
  const u32x4 wv = __builtin_bit_cast(u32x4, v); u32x4 o;
  o.x = cvt_pk_bf16(bf_lo(wv.x) * d0[0], bf_hi(wv.x) * d0[1]); o.y = cvt_pk_bf16(bf_lo(wv.y) * d0[2], bf_hi(wv.y) * d0[3]);
  o.z = cvt_pk_bf16(bf_lo(wv.z) * d1[0], bf_hi(wv.z) * d1[1]); o.w = cvt_pk_bf16(bf_lo(wv.w) * d1[2], bf_hi(wv.w) * d1[3]);
  return __builtin_bit_cast(bf16x8, o);
}
template <bool XW, int PASS, bool RMW>
DI void scan_pass(const bf16_t* qr, const bf16_t* kT, const bf16_t* vT, bf16_t* y, LAS bf16_t* Sb, LAS float* kdec, LAS unsigned char* vimg,
                  int tids, int lane, int r, int h, int w, int et, int dq, int icol, int nc,
                  unsigned qoff0, unsigned vaoff0, unsigned kboff0, unsigned yoff0, float lgf, float lgb) {
  constexpr int SBE = 64 * 264;
  constexpr int pass = PASS;
  {
    f32x16 st0, st1;
#pragma unroll
    for (int i = 0; i < 16; ++i) { st0[i] = 0.f; st1[i] = 0.f; }
    const float lg = pass == 0 ? lgf : lgb;
    const float cd = EX2(lg * 128.0f);
    const float qd = pass == 0 ? EX2(lgf * (float)(icol + 1)) : EX2(lgb * (float)(128 - icol));
    int pbuf = 0;
    if (tids < 128) kdec[tids] = EX2(lg * (float)(PASS == 0 ? 127 - tids : tids));
    __syncthreads();
    bf16x8 qf[16], vr[2], kb0[8];
    u32x2 ovn[8];
#pragma unroll
    for (int gq = 0; gq < 8; ++gq) { ovn[gq].x = 0u; ovn[gq].y = 0u; }
    {
      const int c0 = pass == 0 ? 0 : nc - 1, c1 = pass == 0 ? 1 : nc - 2;
      if constexpr (XW) {
#pragma unroll
        for (int s = 0; s < 16; ++s) qf[s] = ldg16(qr, qoff0 + (unsigned)c0 * 262144u + 1024u * s);
        if constexpr (PASS == 1 && RMW) {
#pragma unroll
          for (int gq = 0; gq < 8; ++gq) ovn[gq] = *(const u32x2*)((const char*)y + (yoff0 + (unsigned)c0 * 524288u + 64u * (gq >> 2) + 16u * (gq & 3)));
        }
      }
#pragma unroll
      for (int s = 0; s < 8; ++s) kb0[s] = ldg16(kT, kboff0 + (unsigned)c0 * 262144u + 1024u * s);
#pragma unroll
      for (int t = 0; t < 2; ++t) {
        const int sv = 2 * dq + t;
        const bf16x8 raw = ldg16(vT, vaoff0 + (unsigned)c0 * 524288u + 1024u * sv);
        *(LAS bf16x8*)(vimg + et * 8192 + sv * 1024 + lane * 16) = scale_tab(raw, kdec + 16 * sv + 8 * h);
        vr[t] = ldg16(vT, vaoff0 + (unsigned)c1 * 524288u + 1024u * sv);
      }
      lds_barrier();
    }
    for (int cc = 0; cc < nc; ++cc) {
      const int c = pass == 0 ? cc : nc - 1 - cc;
      const int k1 = cc + 1 < nc ? cc + 1 : nc - 1, k2 = cc + 2 < nc ? cc + 2 : nc - 1;
      const int cn = pass == 0 ? k1 : nc - 1 - k1, cnn = pass == 0 ? k2 : nc - 1 - k2;
      if constexpr (XW) {
        const unsigned yb = yoff0 + (unsigned)c * 524288u;
        f32x16 yc0, yc1;
#pragma unroll
        for (int i = 0; i < 16; ++i) { yc0[i] = 0.f; yc1[i] = 0.f; }
        const LAS bf16_t* sp = Sb + pbuf * SBE + r * 264 + 8 * h;
#pragma unroll
        for (int sb = 0; sb < 8; ++sb) {
          bf16x8 a0[2], a1[2];
#pragma unroll
          for (int k = 0; k < 2; ++k) { a0[k] = *(const LAS bf16x8*)(sp + 16 * (2 * sb + k)); a1[k] = *(const LAS bf16x8*)(sp + 32 * 264 + 16 * (2 * sb + k)); }
#pragma unroll
          for (int k = 0; k < 2; ++k) { yc0 = MFMA32(a0[k], qf[2 * sb + k], yc0); yc1 = MFMA32(a1[k], qf[2 * sb + k], yc1); }
        }
        asm volatile("" : "+v"(yc0), "+v"(yc1) :: "memory");
#pragma unroll
        for (int s = 0; s < 16; ++s) qf[s] = ldg16(qr, qoff0 + (unsigned)cn * 262144u + 1024u * s);
        const float qe = cc > 0 ? qd : 0.f;
#pragma unroll
        for (int gq = 0; gq < 4; ++gq) {
          u32x2 a; a.x = cvt_pk_bf16(bf_lo(ovn[gq].x) + qe * yc0[4 * gq], bf_hi(ovn[gq].x) + qe * yc0[4 * gq + 1]); a.y = cvt_pk_bf16(bf_lo(ovn[gq].y) + qe * yc0[4 * gq + 2], bf_hi(ovn[gq].y) + qe * yc0[4 * gq + 3]);
          *(u32x2*)((char*)y + (yb + 16u * gq)) = a;
          u32x2 c2; c2.x = cvt_pk_bf16(bf_lo(ovn[4 + gq].x) + qe * yc1[4 * gq], bf_hi(ovn[4 + gq].x) + qe * yc1[4 * gq + 1]); c2.y = cvt_pk_bf16(bf_lo(ovn[4 + gq].y) + qe * yc1[4 * gq + 2], bf_hi(ovn[4 + gq].y) + qe * yc1[4 * gq + 3]);
          *(u32x2*)((char*)y + (yb + 64u + 16u * gq)) = c2;
        }
        if constexpr (PASS == 1 && RMW) {
          const unsigned ybn = yoff0 + (unsigned)cn * 524288u;
#pragma unroll
          for (int gq = 0; gq < 8; ++gq) ovn[gq] = *(const u32x2*)((const char*)y + (ybn + 64u * (gq >> 2) + 16u * (gq & 3)));
        }
      }
#pragma unroll
      for (int i = 0; i < 16; ++i) { st0[i] *= cd; st1[i] *= cd; }
#pragma unroll
      for (int sb = 0; sb < 2; ++sb) {
        bf16x8 a0[4], a1[4];
#pragma unroll
        for (int k = 0; k < 4; ++k) { a0[k] = *(const LAS bf16x8*)(vimg + (cc & 1) * 16384 + (4 * sb + k) * 1024 + lane * 16); a1[k] = *(const LAS bf16x8*)(vimg + (cc & 1) * 16384 + 8192 + (4 * sb + k) * 1024 + lane * 16); }
#pragma unroll
        for (int k = 0; k < 4; ++k) { st0 = MFMA32(a0[k], kb0[4 * sb + k], st0); st1 = MFMA32(a1[k], kb0[4 * sb + k], st1); }
        asm volatile("" : "+v"(st0), "+v"(st1) :: "memory");
#pragma unroll
        for (int k = 0; k < 4; ++k) kb0[4 * sb + k] = ldg16(kT, kboff0 + (unsigned)cn * 262144u + 1024u * (4 * sb + k));
      }
#pragma unroll
      for (int t = 0; t < 2; ++t) {
        const int sv = 2 * dq + t;
        *(LAS bf16x8*)(vimg + ((cc + 1) & 1) * 16384 + et * 8192 + sv * 1024 + lane * 16) = scale_tab(vr[t], kdec + 16 * sv + 8 * h);
        vr[t] = ldg16(vT, vaoff0 + (unsigned)cnn * 524288u + 1024u * sv);
      }
      LAS bf16_t* sw = Sb + (pbuf ^ 1) * SBE + (4 * h) * 264 + 32 * w + r;
#pragma unroll
      for (int i = 0; i < 16; ++i) {
        const int eo = ((i & 3) + 8 * (i >> 2)) * 264;
        const unsigned pkw = cvt_pk_bf16(st0[i], st1[i]);
        sw[eo] = (bf16_t)(pkw & 0xffffu);
        sw[eo + 32 * 264] = (bf16_t)(pkw >> 16);
      }
      lds_barrier();
      pbuf ^= 1;
    }
  }
}
template <bool XW>
DI void scan_item(const bf16_t* qr, const bf16_t* kT, const bf16_t* vT, bf16_t* y, bf16_t* yb, int mode, LAS bf16_t* Sb, LAS float* kdec, LAS unsigned char* vimg,
                  int tids, int lane, int r, int h, int w, int et, int dq, int icol, int nc,
                  unsigned qoff0, unsigned vaoff0, unsigned kboff0, unsigned yoff0, float lgf, float lgb) {
  if (mode != 2) scan_pass<XW, 0, true>(qr, kT, vT, y, Sb, kdec, vimg, tids, lane, r, h, w, et, dq, icol, nc, qoff0, vaoff0, kboff0, yoff0, lgf, lgb);
  if (mode == 0) scan_pass<XW, 1, true>(qr, kT, vT, y, Sb, kdec, vimg, tids, lane, r, h, w, et, dq, icol, nc, qoff0, vaoff0, kboff0, yoff0, lgf, lgb);
  if (mode == 2) scan_pass<XW, 1, false>(qr, kT, vT, yb, Sb, kdec, vimg, tids, lane, r, h, w, et, dq, icol, nc, qoff0, vaoff0, kboff0, yoff0, lgf, lgb);
}
DI void scan_phase(LAS unsigned char* lds, const Params& p, int half) {
  const bf16_t* qr = (const bf16_t*)(p.ws + OFF_BIG);
  const bf16_t* kT = (const bf16_t*)(p.ws + OFF_BIG + 64 * MiB); const bf16_t* vT = (const bf16_t*)(p.ws + OFF_BIG + 96 * MiB);
  bf16_t* y = (bf16_t*)(p.ws + OFF_BIG + 160 * MiB);
  LAS bf16_t* Sb = (LAS bf16_t*)lds;
  LAS float* kdec = (LAS float*)(lds + 69632);
  LAS unsigned char* vimg = lds + 70656;
  const int L = half == 0 ? 2048 : 4096, nc = L / 128, npairs = half == 0 ? 32 : 16, per_xcd = npairs / 8;
  const int tids = tid_fresh(p.wave_s); const int w = p.wave_s, lane = tids & 63, r = lane & 31, h = lane >> 5, ib = w & 3, et = w >> 2, dq = w & 3;
  for (int i = tids; i < 2 * 64 * 264 / 2; i += 512) ((LAS unsigned*)lds)[i] = 0u;
  __syncthreads();
  bf16_t* yb = (bf16_t*)((char*)p.out + 64 * MiB);
  for (int bb = blockIdx.x; bb < 256; bb += gridDim.x) {
    const int jx = bb >> 3;
    int pair, sl, mode;
    if (half == 0) { pair = (bb & 7) * per_xcd + (jx >> 3); sl = jx & 7; mode = 0; }
    else { pair = (bb & 7) * per_xcd + (jx >> 4); sl = jx & 7; mode = 1 + ((jx >> 3) & 1); }
    const int hd = pair & 3, sq = pair >> 2;
    const float lgf = log2_gamma(p.dec_f[hd]), lgb = log2_gamma(p.dec_b[hd]);
    const int icol = 32 * ib + r;
    const int ch0 = sq * (L / 128);
    const unsigned qoff0 = (unsigned)(ch0 * 4 + hd) * 65536u + (unsigned)ib * 16384u + (unsigned)lane * 16u;
    const unsigned vaoff0 = (unsigned)(ch0 * 4 + hd) * 131072u + (unsigned)(2 * sl + et) * 8192u + (unsigned)lane * 16u;
    const unsigned kboff0 = (unsigned)(ch0 * 4 + hd) * 65536u + (unsigned)w * 8192u + (unsigned)lane * 16u;
    const unsigned yoff0 = (unsigned)((sq * L + icol) * 2048 + hd * 512 + 64 * sl + 4 * h) * 2u;
    if (w < 4) scan_item<true>(qr, kT, vT, y, yb, mode, Sb, kdec, vimg, tids, lane, r, h, w, et, dq, icol, nc, qoff0, vaoff0, kboff0, yoff0, lgf, lgb);
    else scan_item<false>(qr, kT, vT, y, yb, mode, Sb, kdec, vimg, tids, lane, r, h, w, et, dq, icol, nc, qoff0, vaoff0, kboff0, yoff0, lgf, lgb);
  }
}

template <bool DRY, bool H1>
DI void intra_phase(LAS unsigned char* lds, const Params& p) {
  const bf16_t* qr = (const bf16_t*)(p.ws + OFF_BIG); const bf16_t* kr = (const bf16_t*)(p.ws + OFF_BIG + 32 * MiB);
  const bf16_t* vT = (const bf16_t*)(p.ws + OFF_BIG + 96 * MiB);
  bf16_t* y = (bf16_t*)(p.ws + OFF_BIG + 160 * MiB); float* ss = (float*)(p.ws + OFF_SS);
  LAS unsigned char* Pimg = lds;
  const int tidi = tid_fresh(p.wave_s); const int w = tidi >> 6, lane = tidi & 63, r = lane & 31, h = lane >> 5, ib = w & 3, wh = w >> 2;
  const bf16_t* yb = (const bf16_t*)((const char*)p.out + 64 * MiB);
  for (int item = blockIdx.x; item < 512; item += gridDim.x) {
    const int hd = item & 3, tb = (item >> 2) * 128;
    const float lgf = log2_gamma(p.dec_f[hd]), lgb = log2_gamma(p.dec_b[hd]);
    const int icol = 32 * ib + r;
    {
      bf16x8 qf[16];
      const unsigned qo = (unsigned)(item) * 65536u + (unsigned)ib * 16384u + (unsigned)lane * 16u;
#pragma unroll
      for (int s = 0; s < 16; ++s) qf[s] = ldg16(qr, qo + 1024u * s);
#pragma unroll
      for (int jj = 0; jj < 2; ++jj) {
        const int jt = 2 * wh + jj;
        f32x16 pt;
#pragma unroll
        for (int i = 0; i < 16; ++i) pt[i] = 0.f;
        const unsigned ko = (unsigned)(item) * 65536u + (unsigned)jt * 16384u + (unsigned)lane * 16u;
#pragma unroll
        for (int s = 0; s < 16; ++s) pt = MFMA32(ldg16(kr, ko + 1024u * s), qf[s], pt);
#pragma unroll
        for (int gq = 0; gq < 4; ++gq) {
          float f[4];
#pragma unroll
          for (int e = 0; e < 4; ++e) {
            const int df = icol - (32 * jt + 8 * gq + 4 * h + e);
            f[e] = pt[4 * gq + e] * EX2(df >= 0 ? lgf * (float)df : lgb * (float)(-df));
          }
          u32x2 a; a.x = rne_pk(f[0], f[1]); a.y = rne_pk(f[2], f[3]);
          *(LAS u32x2*)(Pimg + icol * 272 + (32 * jt + 8 * gq + 4 * h) * 2) = a;
        }
      }
    }
    __syncthreads();
    {
      bf16x8 pf[8];
#pragma unroll
      for (int s = 0; s < 8; ++s) pf[s] = *(const LAS bf16x8*)(Pimg + icol * 272 + (16 * s + 8 * h) * 2);
      float sq2 = 0.f;
      const unsigned vo = (unsigned)(item) * 131072u + (unsigned)(8 * wh) * 8192u + (unsigned)lane * 16u;
      const unsigned yo = (unsigned)((tb + icol) * 2048 + hd * 512 + 256 * wh + 4 * h) * 2u;
      bf16x8 va[2][8]; u32x2 yold[2][4], yol2[2][4];
#pragma unroll
      for (int gq = 0; gq < 4; ++gq) { yol2[0][gq] = (u32x2){0u, 0u}; yol2[1][gq] = (u32x2){0u, 0u}; }
#pragma unroll
      for (int s = 0; s < 8; ++s) va[0][s] = ldg16(vT, vo + 1024u * s);
#pragma unroll
      for (int gq = 0; gq < 4; ++gq) { yold[0][gq] = *(const u32x2*)((const char*)y + (yo + 16u * gq)); if constexpr (H1) yol2[0][gq] = *(const u32x2*)((const char*)yb + (yo + 16u * gq)); }
#pragma unroll
      for (int t = 0; t < 8; ++t) {
        if (t < 7) {
#pragma unroll
          for (int s = 0; s < 8; ++s) va[(t + 1) & 1][s] = ldg16(vT, vo + (unsigned)(t + 1) * 8192u + 1024u * s);
#pragma unroll
          for (int gq = 0; gq < 4; ++gq) { yold[(t + 1) & 1][gq] = *(const u32x2*)((const char*)y + (yo + 64u * (t + 1) + 16u * gq)); if constexpr (H1) yol2[(t + 1) & 1][gq] = *(const u32x2*)((const char*)yb + (yo + 64u * (t + 1) + 16u * gq)); }
        }
        f32x16 yt;
#pragma unroll
        for (int i = 0; i < 16; ++i) yt[i] = 0.f;
#pragma unroll
        for (int s = 0; s < 8; ++s) yt = MFMA32(va[t & 1][s], pf[s], yt);
#pragma unroll
        for (int gq = 0; gq < 4; ++gq) {
          const u32x2 ov = yold[t & 1][gq], o2 = yol2[t & 1][gq];
          const float v0 = bf_lo(ov.x) + bf_lo(o2.x) + yt[4 * gq], v1 = bf_hi(ov.x) + bf_hi(o2.x) + yt[4 * gq + 1], v2 = bf_lo(ov.y) + bf_lo(o2.y) + yt[4 * gq + 2], v3 = bf_hi(ov.y) + bf_hi(o2.y) + yt[4 * gq + 3];
          sq2 += v0 * v0 + v1 * v1 + v2 * v2 + v3 * v3;
          u32x2 a; a.x = cvt_pk_bf16(v0, v1); a.y = cvt_pk_bf16(v2, v3); if (!DRY || v0 == 12345.678f) *(u32x2*)((char*)y + (yo + 64u * t + 16u * gq)) = a;
        }
        __builtin_amdgcn_sched_barrier(0);
      }
      sq2 += shx(sq2, lane, 32);
      if (h == 0 && (!DRY || sq2 == 12345.678f)) ss[((size_t)(tb + icol) * 4 + hd) * 16 + wh] = sq2;
    }
    __syncthreads();
  }
}

constexpr size_t OFF_BAR = 57 * MiB + 512 * 1024;
DI void grid_barrier(unsigned* bar, unsigned epoch) {
  asm volatile("s_waitcnt vmcnt(0)" ::: "memory");
  __syncthreads();
  if (threadIdx.x == 0) {
    __builtin_amdgcn_fence(__ATOMIC_RELEASE, "agent");
    asm volatile("s_waitcnt vmcnt(0)" ::: "memory");
    const unsigned G = gridDim.x, g = blockIdx.x & 7u, ngrp = (G + 7u - g) >> 3, ngroups = G < 8u ? G : 8u;
    unsigned* grp = bar + 3072 + 64 * g;
    const unsigned old = __hip_atomic_fetch_add(grp, 1u, __ATOMIC_RELAXED, __HIP_MEMORY_SCOPE_AGENT);
    if (old + 1u == ngrp * epoch) (void)__hip_atomic_fetch_add(bar, 1u, __ATOMIC_RELAXED, __HIP_MEMORY_SCOPE_AGENT);
    unsigned spins = 0;
    while (__hip_atomic_load(bar, __ATOMIC_RELAXED, __HIP_MEMORY_SCOPE_AGENT) < ngroups * epoch) { __builtin_amdgcn_s_sleep(1); if (++spins > (1u << 24)) break; }
    __builtin_amdgcn_fence(__ATOMIC_ACQUIRE, "agent");
    asm volatile("s_waitcnt vmcnt(0)" ::: "memory");
  }
  __syncthreads();
}

__global__ void __launch_bounds__(512, 2) fwd_megakernel(Params pin) {
  extern __shared__ __attribute__((aligned(16))) unsigned char shm[];
  LAS unsigned char* lds = (LAS unsigned char*)shm;
  const int wave_s = __builtin_amdgcn_readfirstlane((int)(threadIdx.x >> 6));
  const int ph_lo = pin.ph_lo, ph_hi = pin.ph_hi;
  unsigned nbar = 0;
#ifndef PROBE_P
#define PROBE_P 23
#endif
#if DUPMASK & 512
  for (int rep = 0; rep < 2; ++rep)
#else
  const int rep = 0;
#endif
  for (int ph = ph_lo; ph < ((DUPMASK & 512) && rep == 0 ? PROBE_P : ph_hi); ++ph) {
    typedef const __attribute__((address_space(4))) Params* KP;
    KP kp = (KP)__builtin_amdgcn_kernarg_segment_ptr();
    asm volatile("" : "+s"(kp));
    Params p;
    p.xp = kp->xp; p.xs = kp->xs; p.gains = kp->gains; p.ffn_in = kp->ffn_in; p.ffn_out = kp->ffn_out; p.wqkv = kp->wqkv; p.wao = kp->wao; p.sink = kp->sink;
    p.wret_in = kp->wret_in; p.wret_o = kp->wret_o; p.dec_f = kp->dec_f; p.dec_b = kp->dec_b; p.out = kp->out; p.ws = kp->ws; p.ph_lo = ph_lo; p.ph_hi = ph_hi; p.wave_s = wave_s; p.pad_ = 0;
    unsigned char* ws = p.ws;
    const char* hf = (const char*)p.out;
    const char* big = (const char*)(ws + OFF_BIG);
    const int layer = ph >= 9 ? 1 : 0;
    switch (ph) {
      case 0: case 8: convert_layer(lds, p, ph == 0 ? 0 : 1); if (ph == 0) { build_tables(p); norm_phase<0, true>(p, nullptr, 0.f, p.gains); } break;
      case 1: case 6: case 9: case 21: {
        const int i = (ph == 1 || ph == 9) ? 0 : 1;
        PhFfnIn g{hf, (const char*)(ws + i * SZ_FFN_IN), (bf16_t*)(ws + OFF_BIG), 1024};
#ifndef NO_FFNIN
        gemm_phase(lds, g, p.wave_s);
#endif
        } break;
      case 2: case 7: case 10: case 22: case 5: case 15: case 20: {
        PhOutN g;
        g.ws = ws; g.ph = ph; g.first = ph == 2 ? 1 : 0; g.rb = 0; g.nM = 128; g.rep = rep;
        if (ph == 5) { g.A = big + 96 * MiB; g.B = (const char*)(ws + OFF_MIX_OUT); g.K = 1024; g.gi = 3; }
        else if (ph == 15 || ph == 20) { g.A = big + 160 * MiB; g.B = (const char*)(ws + OFF_MIX_OUT); g.K = 2048; g.gi = 9; g.nM = 64; g.rb = ph == 15 ? 0 : TH; }
        else { const int i = (ph == 2 || ph == 10) ? 0 : 1; g.A = big; g.B = (const char*)(ws + OFF_FFN_OUT0 + i * SZ_FFN_OUT); g.K = DFF; g.gi = ph == 2 ? 1 : ph == 7 ? 5 : ph == 10 ? 7 : 11; }
#ifndef NO_OUT
        gemm_phase(lds, g, p.wave_s);
#endif
        } break;
      case 3: {
        PhQkv g{ws, hf, 1024};
#ifndef NO_QKV
        gemm_phase(lds, g, p.wave_s);
#endif
        } break;
#ifndef NO_ATTN
      case 4: attn_phase(p);
#if DUPMASK & 2
        attn_phase(p);
#endif
        break;
#endif
      case 11: case 16: {
        PhRetIn g{ws, hf, ph == 11 ? 0 : TH, 1024};
#ifndef NO_RETIN
        gemm_phase(lds, g, p.wave_s);
#endif
        } break;
#ifndef NO_SCAN
      case 12: case 17: scan_phase(lds, p, ph == 12 ? 0 : 1);
#if DUPMASK & 1
        scan_phase(lds, p, ph == 12 ? 0 : 1);
#endif
        break;
#endif
#ifndef NO_INTRA
      case 13: intra_phase<false, false>(lds, p); break;
      case 18: intra_phase<false, true>(lds, p); break;
#endif
      case 14: case 19: {
        PhGate g{hf, (const char*)(ws + OFF_MIX_IN), (bf16_t*)(ws + OFF_BIG + 160 * MiB), (const float*)(ws + OFF_SS), ph == 14 ? 0 : TH, 1024};
#ifndef NO_GATE
        gemm_phase(lds, g, p.wave_s);
#endif
        } break;
      default: break;
    }
    (void)layer;
#if ONE_LAUNCH
    if (ph + 1 < ph_hi || (DUPMASK & 512)) {
      if (ph_hi > NPHASE) cg::this_grid().sync();
      {
#if DUPMASK & 32
        if (ph == 1 && false) { for (int e = 0; e < 20; ++e) { nbar += 1; grid_barrier((unsigned*)(p.ws + OFF_BAR), nbar); } }
#endif
        if (ph != 15) { nbar += 1; grid_barrier((unsigned*)(p.ws + OFF_BAR), nbar); }
      }
    }
#endif
  }
}

extern "C" void kernel_launch(void* const* d_in, const int* in_sizes, int n_in, void* d_out, int out_size, void* d_ws, size_t ws_size, hipStream_t stream) {
  static int grid = 0;
  if (grid == 0) {
    if (ws_size < WS_NEED) { fprintf(stderr, "kernel_launch: workspace too small: %zu < %zu\n", ws_size, (size_t)WS_NEED); }
    int dev = 0, cus = 0, per_cu = 0;
    hipGetDevice(&dev);
    hipDeviceGetAttribute(&cus, hipDeviceAttributeMultiprocessorCount, dev);
    hipFuncSetAttribute((const void*)fwd_megakernel, hipFuncAttributeMaxDynamicSharedMemorySize, LDS_BYTES);
    hipOccupancyMaxActiveBlocksPerMultiprocessor(&per_cu, (const void*)fwd_megakernel, 512, LDS_BYTES);
    if (per_cu < 1) per_cu = 1;
    grid = cus * 1;
    (void)hipGetLastError();
  }
  Params p{};
  p.xp = (const float*)d_in[0]; p.xs = (const float*)d_in[1]; p.gains = (const float*)d_in[2]; p.ffn_in = (const float*)d_in[3]; p.ffn_out = (const float*)d_in[4];
  p.wqkv = (const float*)d_in[5]; p.wao = (const float*)d_in[6]; p.sink = (const float*)d_in[7]; p.wret_in = (const float*)d_in[8]; p.wret_o = (const float*)d_in[9];
  p.dec_f = (const float*)d_in[10]; p.dec_b = (const float*)d_in[11];
  p.out = (float*)d_out; p.ws = (unsigned char*)d_ws;
#if ONE_LAUNCH
  p.ph_lo = 0; p.ph_hi = NPHASE;
  (void)hipMemsetAsync((unsigned char*)d_ws + OFF_BAR, 0, 16384, stream);
  void* args[] = {&p};
  hipError_t e = hipLaunchCooperativeKernel((const void*)fwd_megakernel, dim3(grid), dim3(512), args, LDS_BYTES, stream);
  if (e != hipSuccess) fprintf(stderr, "cooperative launch failed: %s (grid %d)\n", hipGetErrorString(e), grid);
#else
  for (int ph = 0; ph < NPHASE; ++ph) {
    p.ph_lo = ph; p.ph_hi = ph + 1;
    hipLaunchKernelGGL(fwd_megakernel, dim3(grid), dim3(512), LDS_BYTES, stream, p);
  }
#endif
}
```
